# Optimizing an MI355X kernel written in HIP

```python
import jax
import jax.numpy as jnp
from jax import lax

D_MODEL = 1024
BATCH = 4
SEQ = 4096
DEPTH = 2

N_A_LAYERS = DEPTH - DEPTH // 2
N_B_LAYERS = DEPTH // 2
N_DENSE = (DEPTH + 1) // 2
N_MOE = DEPTH // 2

HGRN_EXPAND = 128
HGRN_HEADS = D_MODEL // HGRN_EXPAND
HGRN_DV = D_MODEL // HGRN_HEADS
HGRN_CHUNK = 64

ATT_HEAD_DIM = 64
ATT_HEADS = D_MODEL // ATT_HEAD_DIM
DILATED_BRANCHES = ((128, 1), (512, 4), (2048, 16))
N_BRANCH = len(DILATED_BRANCHES)
BAND = DILATED_BRANCHES[0][0] // DILATED_BRANCHES[0][1]
ATT_SCALE = ATT_HEAD_DIM ** -0.5
ROPE_THETA = 10000.0

D_FF = 2816
N_EXPERTS = 8
TOP_K = 2
D_FF_EXPERT = 3584
EPS = 1e-6

kernel_name = "hgrn2_yoco_dilated_moe_trunk"


def rms_norm(x, g):
    xf = x.astype(jnp.float32)
    y = xf * lax.rsqrt(jnp.mean(xf * xf, axis=-1, keepdims=True) + EPS)
    return (y * g.astype(jnp.float32)).astype(x.dtype)


def rope(t, pos):
    half = t.shape[-1] // 2
    inv_freq = ROPE_THETA ** (-jnp.arange(half, dtype=jnp.float32) / half)
    ang = pos.astype(jnp.float32)[:, None] * inv_freq[None, :]
    cos = jnp.cos(ang)[None, :, None, :]
    sin = jnp.sin(ang)[None, :, None, :]
    tf = t.astype(jnp.float32)
    t1, t2 = tf[..., :half], tf[..., half:]
    return jnp.concatenate([t1 * cos - t2 * sin, t2 * cos + t1 * sin], axis=-1)


def swiglu(h, w_gate, w_up, w_down):
    return (jax.nn.silu(h @ w_gate) * (h @ w_up)) @ w_down


def hgrn2_mixer(h, w_in, lower_bound, out_norm, w_out):
    B, S, _ = h.shape
    H, DK, DV, C = HGRN_HEADS, HGRN_EXPAND, HGRN_DV, HGRN_CHUNK
    N = S // C
    q, f_logit, v, g = jnp.split(h @ w_in, 4, axis=-1)
    lb = lower_bound.astype(jnp.float32)
    f = lb + (1.0 - lb) * jax.nn.sigmoid(f_logit.astype(jnp.float32))
    k = 1.0 - f

    def chunks(t):
        return t.astype(jnp.float32).reshape(B, N, C, H, -1).transpose(0, 3, 1, 2, 4)

    q_c, k_c, v_c = chunks(q), chunks(k), chunks(v)
    b = jnp.cumsum(chunks(jnp.log(f)), axis=3)
    b_last = b[:, :, :, -1:, :]
    q_dec = q_c * jnp.exp(b)
    k_dec = k_c * jnp.exp(-b)
    k_end = k_c * jnp.exp(b_last - b)
    causal = jnp.tril(jnp.ones((C, C), dtype=bool))
    scores = jnp.where(causal, jnp.einsum("bhncd,bhnsd->bhncs", q_dec, k_dec), 0.0)
    o_intra = jnp.einsum("bhncs,bhnsv->bhncv", scores, v_c)
    kv_chunk = jnp.einsum("bhnsd,bhnsv->bhndv", k_end, v_c)
    decay = jnp.exp(b_last[:, :, :, 0, :])

    def step(state, inp):
        dcy, kv = inp
        return dcy[..., None] * state + kv, state

    state0 = jnp.zeros((B, H, DK, DV), jnp.float32)
    _, states = lax.scan(step, state0, (jnp.moveaxis(decay, 2, 0), jnp.moveaxis(kv_chunk, 2, 0)))
    o_inter = jnp.einsum("bhncd,nbhdv->bhncv", q_dec, states)
    o = (o_intra + o_inter).transpose(0, 2, 3, 1, 4).reshape(B, S, H, DV)
    o = rms_norm(o, out_norm) * jax.nn.silu(g.astype(jnp.float32)).reshape(B, S, H, DV)
    return o.reshape(B, S, D_MODEL).astype(h.dtype) @ w_out


def dilated_branch(q, k, v, dil):
    B, S, H, D = q.shape
    L = S // dil
    nb = -(-L // BAND)
    Lp = nb * BAND

    def to_blocks(t):
        t = t.reshape(B, L, dil, H, D).transpose(0, 2, 1, 3, 4)
        t = jnp.pad(t, ((0, 0), (0, 0), (0, Lp - L), (0, 0), (0, 0)))
        return t.reshape(B, dil, nb, BAND, H, D)

    def with_prev(t):
        prev = jnp.pad(t[:, :, :-1], ((0, 0), (0, 0), (1, 0), (0, 0), (0, 0), (0, 0)))
        return jnp.concatenate([prev, t], axis=3)

    qb = to_blocks(q)
    kb = with_prev(to_blocks(k))
    vb = with_prev(to_blocks(v))
    s = jnp.einsum("brnqhd,brnkhd->brnhqk", qb, kb)
    qi = jnp.arange(BAND)[:, None]
    ki = jnp.arange(2 * BAND)[None, :]
    dist = qi + BAND - ki
    band_ok = (dist >= 0) & (dist <= BAND)
    valid = band_ok[None] & ((jnp.arange(nb)[:, None, None] > 0) | (ki >= BAND)[None])
    s = jnp.where(valid[None, None, :, None], s, -jnp.inf)
    m = jnp.max(s, axis=-1)
    p = jnp.exp(s - m[..., None])
    l = jnp.sum(p, axis=-1)
    o = jnp.einsum("brnhqk,brnkhd->brnqhd", p, vb) / jnp.swapaxes(l, 3, 4)[..., None]
    lse = jnp.swapaxes(m + jnp.log(l), 3, 4)
    o = o.reshape(B, dil, Lp, H, D)[:, :, :L].transpose(0, 2, 1, 3, 4).reshape(B, S, H, D)
    lse = lse.reshape(B, dil, Lp, H)[:, :, :L].transpose(0, 2, 1, 3).reshape(B, S, H)
    return o, lse


def shared_kv(h, kv_norm, w_kv, pos):
    B, S, _ = h.shape
    kv = (rms_norm(h, kv_norm) @ w_kv).reshape(B, S, 2, N_BRANCH, ATT_HEADS, ATT_HEAD_DIM)
    keys = [rope(kv[:, :, 0, i], pos) for i in range(N_BRANCH)]
    values = [kv[:, :, 1, i].astype(jnp.float32) for i in range(N_BRANCH)]
    return keys, values


def dilated_mixer(h, w_q, w_out, keys, values, pos):
    B, S, _ = h.shape
    q = (h @ w_q).reshape(B, S, N_BRANCH, ATT_HEADS, ATT_HEAD_DIM)
    outs, lses = [], []
    for i, (_, dil) in enumerate(DILATED_BRANCHES):
        o_i, lse_i = dilated_branch(rope(q[:, :, i], pos) * ATT_SCALE, keys[i], values[i], dil)
        outs.append(o_i)
        lses.append(lse_i)
    wts = jax.nn.softmax(jnp.stack(lses, axis=0), axis=0)
    o = jnp.sum(wts[..., None] * jnp.stack(outs, axis=0), axis=0)
    return o.reshape(B, S, D_MODEL).astype(h.dtype) @ w_out


def moe_swiglu(h, w_router, w_gate, w_up, w_down):
    B, S, Dm = h.shape
    t = h.reshape(B * S, Dm)
    probs = jax.nn.softmax((t @ w_router).astype(jnp.float32), axis=-1)
    top_p, top_i = lax.top_k(probs, TOP_K)
    top_p = top_p / jnp.sum(top_p, axis=-1, keepdims=True)
    combine = jnp.sum(jax.nn.one_hot(top_i, N_EXPERTS, dtype=jnp.float32) * top_p[..., None], axis=1).astype(h.dtype)
    out = jnp.zeros_like(t)
    for e in range(N_EXPERTS):
        out = out + combine[:, e:e + 1] * swiglu(t, w_gate[e], w_up[e], w_down[e])
    return out.reshape(B, S, Dm)


def setup_inputs(seed: int = 0) -> dict:
    key = jax.random.key(seed)
    ks = jax.random.split(key, 20)
    f32 = jnp.float32

    def dense(k, shape, fan_in):
        return jax.random.normal(k, shape, f32) * fan_in ** -0.5

    def gain(k, shape):
        return 1.0 + 0.02 * jax.random.normal(k, shape, f32)

    att_w = ATT_HEADS * ATT_HEAD_DIM
    return {
        "x": jax.random.normal(ks[0], (BATCH, SEQ, D_MODEL), f32),
        "attn_norm": gain(ks[1], (DEPTH, D_MODEL)),
        "ffn_norm": gain(ks[2], (DEPTH, D_MODEL)),
        "hgrn_w_in": dense(ks[3], (N_A_LAYERS, D_MODEL, 4 * D_MODEL), D_MODEL),
        "hgrn_lower_bounds": 0.1 * jax.random.normal(ks[4], (N_A_LAYERS + 1, D_MODEL), f32),
        "hgrn_out_norm": gain(ks[5], (N_A_LAYERS, HGRN_DV)),
        "hgrn_w_out": dense(ks[6], (N_A_LAYERS, D_MODEL, D_MODEL), D_MODEL),
        "kv_norm": gain(ks[7], (D_MODEL,)),
        "w_kv": dense(ks[8], (D_MODEL, 2 * N_BRANCH * att_w), D_MODEL),
        "dil_w_q": dense(ks[9], (N_B_LAYERS, D_MODEL, N_BRANCH * att_w), D_MODEL),
        "dil_w_out": dense(ks[10], (N_B_LAYERS, att_w, D_MODEL), att_w),
        "ffn_w_gate": dense(ks[11], (N_DENSE, D_MODEL, D_FF), D_MODEL),
        "ffn_w_up": dense(ks[12], (N_DENSE, D_MODEL, D_FF), D_MODEL),
        "ffn_w_down": dense(ks[13], (N_DENSE, D_FF, D_MODEL), D_FF),
        "moe_w_router": dense(ks[14], (N_MOE, D_MODEL, N_EXPERTS), D_MODEL),
        "moe_w_gate": dense(ks[15], (N_MOE, N_EXPERTS, D_MODEL, D_FF_EXPERT), D_MODEL),
        "moe_w_up": dense(ks[16], (N_MOE, N_EXPERTS, D_MODEL, D_FF_EXPERT), D_MODEL),
        "moe_w_down": dense(ks[17], (N_MOE, N_EXPERTS, D_FF_EXPERT, D_MODEL), D_FF_EXPERT),
        "final_norm": gain(ks[18], (D_MODEL,)),
    }


def reference(x, attn_norm, ffn_norm, hgrn_w_in, hgrn_lower_bounds, hgrn_out_norm, hgrn_w_out,
              kv_norm, w_kv, dil_w_q, dil_w_out, ffn_w_gate, ffn_w_up, ffn_w_down,
              moe_w_router, moe_w_gate, moe_w_up, moe_w_down, final_norm):
    pos = jnp.arange(x.shape[1])
    lbs = jnp.cumsum(jax.nn.softmax(hgrn_lower_bounds.astype(jnp.float32), axis=0), axis=0)
    h = x
    keys, values = None, None
    for layer in range(DEPTH):
        if layer == N_A_LAYERS:
            keys, values = shared_kv(h, kv_norm, w_kv, pos)
        hn = rms_norm(h, attn_norm[layer])
        if layer < N_A_LAYERS:
            h = h + hgrn2_mixer(hn, hgrn_w_in[layer], lbs[layer], hgrn_out_norm[layer], hgrn_w_out[layer])
        else:
            j = layer - N_A_LAYERS
            h = h + dilated_mixer(hn, dil_w_q[j], dil_w_out[j], keys, values, pos)
        hn = rms_norm(h, ffn_norm[layer])
        if layer % 2 == 0:
            i = layer // 2
            h = h + swiglu(hn, ffn_w_gate[i], ffn_w_up[i], ffn_w_down[i])
        else:
            i = layer // 2
            h = h + moe_swiglu(hn, moe_w_router[i], moe_w_gate[i], moe_w_up[i], moe_w_down[i])
    return rms_norm(h, final_norm)
```

```cpp
#include <hip/hip_runtime.h>
#include <cstdio>
#include <cstdint>
#include <cmath>
namespace pg8 {
#define PG8_LAS __attribute__((address_space(3)))
typedef unsigned short bf16_t;
typedef short bf16x8 __attribute__((ext_vector_type(8)));
typedef float f32x4 __attribute__((ext_vector_type(4)));
typedef unsigned u32x4 __attribute__((ext_vector_type(4)));
constexpr int BM = 256, BK = 64, HALF = 128, HTB = HALF * BK * 2  , STAGE_BYTES = 8 * HTB, NXCD = 8, WGM = 8;

__host__ __device__ __forceinline__ int lds_byte(int r, int c) { const int st = (r >> 4) * 2 + (c >> 5), rr = r & 15, cc = c & 31, ob = rr * 64 + cc * 2; return st * 1024 + (ob ^ (((ob >> 9) & 1) << 5)); }
__host__ __device__ __forceinline__ void stage_rc(int b, int& R, int& C) { const int st = b / 1024, sb = b % 1024, swz = sb ^ (((sb >> 9) & 1) << 5); R = (st >> 1) * 16 + swz / 64; C = (st & 1) * 32 + (swz % 64) / 2; }
__host__ __device__ __forceinline__ int perm32(int rho) { const int n = rho >> 4, i = rho & 15; return 8 * (i >> 2) + 4 * n + (i & 3); }

struct Unit { int pm, pn; };
struct Gemm { const bf16_t* A; const bf16_t* Bt; int M, N, K; };

struct StaticOrder {
    int nM, nN, nwg, G, c;
    __host__ __device__ void init(int M, int N, int G_, int c_) { nM = M / BM; nN = N / BM; nwg = nM * nN; G = G_; c = c_; }
    __host__ __device__ bool next(int i, Unit& u) const {
        const long L = (long)i * G + c; if (L >= nwg) return false;
        int wgid = (int)L; { const int q = nwg / NXCD, r = nwg % NXCD, xcd = wgid % NXCD, off = wgid / NXCD; wgid = (xcd < r ? xcd * (q + 1) : r * (q + 1) + (xcd - r) * q) + off; }
        const int nig = WGM * nN, gid = wgid / nig, fm = gid * WGM, gsz = (nM - fm) < WGM ? (nM - fm) : WGM;
        u.pm = fm + ((wgid % nig) % gsz); u.pn = (wgid % nig) / gsz; return true;
    }
    __device__ __forceinline__ void a_ready(const Unit&) const {}
    __device__ __forceinline__ void done(const Unit&) const {}
};

__device__ __forceinline__ unsigned cvt_pk_bf16(float lo, float hi) { unsigned r; asm volatile("v_cvt_pk_bf16_f32 %0, %1, %2" : "=v"(r) : "v"(lo), "v"(hi)); return r; }

constexpr float RMS_EPS = 1e-6f;
template <bool SLOTS> __device__ __forceinline__ float row_ss(const float* ss, int row) {
    if (!SLOTS) return ss[row];
    const f32x4* p = (const f32x4*)(ss + (size_t)row * 16); const f32x4 a = p[0], b = p[1], c = p[2], d = p[3];
    return (((a[0] + a[1]) + (a[2] + a[3])) + ((b[0] + b[1]) + (b[2] + b[3]))) + (((c[0] + c[1]) + (c[2] + c[3])) + ((d[0] + d[1]) + (d[2] + d[3])));
}
template <int MODE> struct EpiScale {
    static constexpr bool PERM = true, AFTER_DRAIN = false;
    bf16_t* O; int ldc; const float* ss; const float* cosT; const float* sinT; float qscale;
    __device__ __forceinline__ void operator()(const f32x4 (&acc)[2][2][4][2], const Unit& u, int wr, int wc, int fr, int fq) const {
        const int row0 = u.pm * BM + wr * 64 + fr, col0 = u.pn * BM + wc * 32 + 8 * fq;
        const int kind = (MODE == 1) ? (u.pn < 12 ? 1 : (u.pn < 24 ? 0 : 2)) : 0;
        const int j4 = ((4 * wc + fq) & 7) * 4;
#pragma unroll
        for (int ai = 0; ai < 2; ++ai)
#pragma unroll
            for (int m = 0; m < 4; ++m) { const int row = row0 + ai * HALF + m * 16;
                const float s = __builtin_amdgcn_rsqf(row_ss<MODE == 1>(ss, row) * (1.0f / 1024.0f) + RMS_EPS);
                f32x4 cs = (f32x4){1.f, 1.f, 1.f, 1.f}, sn = (f32x4){0.f, 0.f, 0.f, 0.f};
                if (MODE == 1 && kind) { const int pos = row & 4095; cs = *(const f32x4*)(cosT + pos * 32 + j4); sn = *(const f32x4*)(sinT + pos * 32 + j4); }
                bf16_t* rowp = O + (size_t)row * ldc + col0;
#pragma unroll
                for (int bj = 0; bj < 2; ++bj) { f32x4 v0 = acc[ai][bj][m][0] * s, v1 = acc[ai][bj][m][1] * s;
                    if (MODE == 1 && kind) { const f32x4 r0 = v0 * cs - v1 * sn, r1 = v1 * cs + v0 * sn; v0 = r0; v1 = r1; if (kind == 2) { v0 = v0 * qscale; v1 = v1 * qscale; } }
                    u32x4 w; w.x = cvt_pk_bf16(v0[0], v0[1]); w.y = cvt_pk_bf16(v0[2], v0[3]); w.z = cvt_pk_bf16(v1[0], v1[1]); w.w = cvt_pk_bf16(v1[2], v1[3]);
                    *(u32x4*)(rowp + bj * HALF) = w; } }
    }
};
template <bool SS> struct EpiResid {
    static constexpr bool PERM = true, AFTER_DRAIN = false;
    const float* resid; float* hout; bf16_t* hb; float* ssout;
    __device__ __forceinline__ void operator()(const f32x4 (&acc)[2][2][4][2], const Unit& u, int wr, int wc, int fr, int fq) const {
        const int row0 = u.pm * BM + wr * 64 + fr, col0 = u.pn * BM + wc * 32 + 8 * fq;
#pragma unroll
        for (int ai = 0; ai < 2; ++ai)
#pragma unroll
            for (int m = 0; m < 4; ++m) { const int row = row0 + ai * HALF + m * 16; float part = 0.f;
#pragma unroll
                for (int bj = 0; bj < 2; ++bj) { const size_t off = (size_t)row * 1024 + col0 + bj * HALF;
                    const f32x4 r0 = *(const f32x4*)(resid + off), r1 = *(const f32x4*)(resid + off + 4);
                    const f32x4 v0 = acc[ai][bj][m][0] + r0, v1 = acc[ai][bj][m][1] + r1;
                    *(f32x4*)(hout + off) = v0; *(f32x4*)(hout + off + 4) = v1;
                    u32x4 w; w.x = cvt_pk_bf16(v0[0], v0[1]); w.y = cvt_pk_bf16(v0[2], v0[3]); w.z = cvt_pk_bf16(v1[0], v1[1]); w.w = cvt_pk_bf16(v1[2], v1[3]);
                    *(u32x4*)(hb + off) = w;
                    if (SS) part += (v0[0] * v0[0] + v0[1] * v0[1]) + (v0[2] * v0[2] + v0[3] * v0[3]) + (v1[0] * v1[0] + v1[1] * v1[1]) + (v1[2] * v1[2] + v1[3] * v1[3]); }
                if (SS) { part += __shfl_xor(part, 16); part += __shfl_xor(part, 32); if (fq == 0) ssout[(size_t)row * 16 + u.pn * 4 + wc] = part; } }
    }
};
template <bool SLOTS> struct EpiSwiglu {
    static constexpr bool PERM = true, AFTER_DRAIN = false;
    bf16_t* O; int ldc; const float* ss; int nN;
    __device__ __forceinline__ void operator()(const f32x4 (&acc)[2][2][4][2], const Unit& u, int wr, int wc, int fr, int fq) const {
        const int pnl = u.pn % nN; const int row0 = u.pm * BM + wr * 64 + fr, col0 = pnl * HALF + wc * 32 + 8 * fq;
#pragma unroll
        for (int ai = 0; ai < 2; ++ai)
#pragma unroll
            for (int m = 0; m < 4; ++m) { const int row = row0 + ai * HALF + m * 16;
                const float s = __builtin_amdgcn_rsqf(row_ss<SLOTS>(ss, row) * (1.0f / 1024.0f) + RMS_EPS);
                f32x4 o[2];
#pragma unroll
                for (int n = 0; n < 2; ++n) { const f32x4 g = acc[ai][0][m][n] * s, up = acc[ai][1][m][n] * s;
#pragma unroll
                    for (int i = 0; i < 4; ++i) o[n][i] = g[i] * __builtin_amdgcn_rcpf(1.0f + __expf(-g[i])) * up[i]; }
                u32x4 w; w.x = cvt_pk_bf16(o[0][0], o[0][1]); w.y = cvt_pk_bf16(o[0][2], o[0][3]); w.z = cvt_pk_bf16(o[1][0], o[1][1]); w.w = cvt_pk_bf16(o[1][2], o[1][3]);
                *(u32x4*)(O + (size_t)row * ldc + col0) = w; }
    }
};
struct EpiDownMoe {
    static constexpr bool PERM = true, AFTER_DRAIN = false;
    bf16_t* Y; const float* w;
    __device__ __forceinline__ void operator()(const f32x4 (&acc)[2][2][4][2], const Unit& u, int wr, int wc, int fr, int fq) const {
        const int pnl = u.pn & 3; const int row0 = u.pm * BM + wr * 64 + fr, col0 = pnl * BM + wc * 32 + 8 * fq;
#pragma unroll
        for (int ai = 0; ai < 2; ++ai)
#pragma unroll
            for (int m = 0; m < 4; ++m) { const int row = row0 + ai * HALF + m * 16; const float s = w[row];
                bf16_t* rowp = Y + (size_t)row * 1024 + col0;
#pragma unroll
                for (int bj = 0; bj < 2; ++bj) { const f32x4 v0 = acc[ai][bj][m][0] * s, v1 = acc[ai][bj][m][1] * s;
                    u32x4 w4; w4.x = cvt_pk_bf16(v0[0], v0[1]); w4.y = cvt_pk_bf16(v0[2], v0[3]); w4.z = cvt_pk_bf16(v1[0], v1[1]); w4.w = cvt_pk_bf16(v1[2], v1[3]);
                    *(u32x4*)(rowp + bj * HALF) = w4; } }
    }
};
struct MoeOrder {
    int nM, nN, nwg, G, c; int t1, t2, t3, t4, t5, t6, t7;
    __device__ __forceinline__ bool next(int i, Unit& u) const {
        const long L = (long)i * G + c; if (L >= nwg) return false;
        int wgid = (int)L; { const int q = nwg / NXCD, r = nwg % NXCD, xcd = wgid % NXCD, off = wgid / NXCD; wgid = (xcd < r ? xcd * (q + 1) : r * (q + 1) + (xcd - r) * q) + off; }
        const int nig = WGM * nN, gid = wgid / nig, fm = gid * WGM, gsz = (nM - fm) < WGM ? (nM - fm) : WGM;
        const int pm = fm + ((wgid % nig) % gsz), pnl = (wgid % nig) / gsz;
        const int e = (pm >= t1) + (pm >= t2) + (pm >= t3) + (pm >= t4) + (pm >= t5) + (pm >= t6) + (pm >= t7);
        u.pm = pm; u.pn = e * nN + pnl; return true;
    }
    __device__ __forceinline__ void a_ready(const Unit&) const {}
    __device__ __forceinline__ void done(const Unit&) const {}
};
template <class Epi, class Sched, bool ALIGN_EPI = false, bool SP2 = false>
__device__ __forceinline__ void gemm_phase(PG8_LAS unsigned char* lds, const Gemm g, const Sched& S, const Epi& E) {
    const int tid = threadIdx.x, wid = __builtin_amdgcn_readfirstlane(tid >> 6), lane = tid & 63, wr = wid >> 2, wc = wid & 3, fr = lane & 15, fq = lane >> 4;
    const int K = g.K, nt = K / BK;
    unsigned voffA[2], voffB[2];
#pragma unroll
    for (int i = 0; i < 2; ++i) { int R, C; stage_rc(tid * 16 + i * 8192, R, C); const int Rb = Epi::PERM ? ((R & ~31) + perm32(R & 31)) : R;
        voffA[i] = (unsigned)(R * K + C) * 2u; voffB[i] = (unsigned)(Rb * K + C) * 2u; }
    const size_t kstep = (size_t)(BK * 2);
    const size_t hstep = (size_t)HALF * K * 2;
    const size_t tstep = 2 * hstep;
    const unsigned ldsw = (unsigned)wid * 1024u;
    const int aoff = lds_byte(wr * 64 + fr, fq * 8), boff = lds_byte(wc * 32 + fr, fq * 8);
#define PG8_SA(b, h) (((b) * 2 + (h)) * HTB)
#define PG8_SB(b, h) ((4 + (b) * 2 + (h)) * HTB)
#define PG8_STAGE(bufoff, gbase, voff) do { _Pragma("unroll") for (int _i = 0; _i < 2; ++_i) \
        __builtin_amdgcn_global_load_lds((const unsigned*)((const char*)(gbase) + (voff)[_i]), (PG8_LAS unsigned*)(lds + (bufoff) + ldsw + _i * 8192), 16, 0, 0); } while (0)
#define PG8_LDA(dst, b, h) do { _Pragma("unroll") for (int m = 0; m < 4; ++m) _Pragma("unroll") for (int k = 0; k < 2; ++k) dst[m][k] = *(const PG8_LAS bf16x8*)(lds + PG8_SA(b, h) + aoff + m * 2048 + k * 1024); } while (0)
#define PG8_LDB(dst, b, h) do { _Pragma("unroll") for (int n = 0; n < 2; ++n) _Pragma("unroll") for (int k = 0; k < 2; ++k) dst[n][k] = *(const PG8_LAS bf16x8*)(lds + PG8_SB(b, h) + boff + n * 2048 + k * 1024); } while (0)
#define PG8_MMA(ai, bj, At, Bt) do { __builtin_amdgcn_s_setprio(1); _Pragma("unroll") for (int m = 0; m < 4; ++m) _Pragma("unroll") for (int n = 0; n < 2; ++n) _Pragma("unroll") for (int k = 0; k < 2; ++k) \
        acc[ai][bj][m][n] = __builtin_amdgcn_mfma_f32_16x16x32_bf16(Bt[n][k], At[m][k], acc[ai][bj][m][n], 0, 0, 0); __builtin_amdgcn_s_setprio(0); } while (0)
#define PG8_WAIT_V(n) asm volatile("s_waitcnt vmcnt(" #n ")" ::: "memory")
#define PG8_WAIT_L(n) asm volatile("s_waitcnt lgkmcnt(" #n ")" ::: "memory")
#define PG8_BAR __builtin_amdgcn_s_barrier()
#define PG8_SCHED __builtin_amdgcn_sched_barrier(0)
    Unit cur, nxt; int ui = 0;
    if (!S.next(0, cur)) return;
    f32x4 acc[2][2][4][2];
#pragma unroll
    for (int a = 0; a < 2; ++a)
#pragma unroll
        for (int b = 0; b < 2; ++b)
#pragma unroll
            for (int m = 0; m < 4; ++m)
#pragma unroll
                for (int n = 0; n < 2; ++n) acc[a][b][m][n] = (f32x4){0.f, 0.f, 0.f, 0.f};
    bf16x8 At[4][2], B0[2][2], B1[2][2];
    const char* cA = (const char*)g.A + (size_t)cur.pm * tstep; const char* cB = (const char*)g.Bt + (size_t)cur.pn * tstep;
    S.a_ready(cur);
    if constexpr (SP2) {
        PG8_STAGE(PG8_SB(0, 0), cB, voffB); PG8_STAGE(PG8_SB(0, 1), cB + hstep, voffB); PG8_STAGE(PG8_SA(0, 0), cA, voffA); PG8_STAGE(PG8_SA(0, 1), cA + hstep, voffA);
        if (wr == 1) PG8_BAR;
        PG8_WAIT_V(2); PG8_BAR;
        PG8_STAGE(PG8_SB(1, 0), cB + kstep, voffB); PG8_STAGE(PG8_SA(1, 0), cA + kstep, voffA); PG8_STAGE(PG8_SB(1, 1), cB + hstep + kstep, voffB);
        PG8_WAIT_V(6); PG8_BAR;
    } else {
        PG8_STAGE(PG8_SB(0, 0), cB, voffB); PG8_STAGE(PG8_SA(0, 0), cA, voffA); PG8_STAGE(PG8_SB(0, 1), cB + hstep, voffB); PG8_STAGE(PG8_SA(0, 1), cA + hstep, voffA);
        if (wr == 1) PG8_BAR;
        PG8_WAIT_V(4); PG8_BAR;
        PG8_STAGE(PG8_SB(1, 0), cB + kstep, voffB); PG8_STAGE(PG8_SA(1, 0), cA + kstep, voffA); PG8_STAGE(PG8_SB(1, 1), cB + hstep + kstep, voffB);
        PG8_WAIT_V(6); PG8_BAR;
    }
    for (;;) {
        const bool has_next = S.next(ui + 1, nxt);
        const char* nA = has_next ? (const char*)g.A + (size_t)nxt.pm * tstep : cA; const char* nB = has_next ? (const char*)g.Bt + (size_t)nxt.pn * tstep : cB;
        for (int t = 0; t < nt; t += 2) {
            const bool last = (t == nt - 2);
            const char* a1 = cA + (size_t)(t + 1) * kstep;
            const char* a2 = last ? nA : cA + (size_t)(t + 2) * kstep; const char* b2 = last ? nB : cB + (size_t)(t + 2) * kstep;
            const char* a3 = a2 + kstep; const char* b3 = b2 + kstep;
            if (last && has_next) S.a_ready(nxt);
            if constexpr (SP2) {
            PG8_LDB(B0, 0, 0); PG8_LDB(B1, 0, 1); PG8_SCHED; PG8_LDA(At, 0, 0); PG8_STAGE(PG8_SA(1, 1), a1 + hstep, voffA);
            PG8_WAIT_V(8); PG8_WAIT_L(0); PG8_BAR; PG8_MMA(0, 0, At, B0); PG8_MMA(0, 1, At, B1); PG8_BAR; PG8_SCHED;
            PG8_LDA(At, 0, 1); PG8_STAGE(PG8_SB(0, 0), b2, voffB); PG8_STAGE(PG8_SB(0, 1), b2 + hstep, voffB); PG8_STAGE(PG8_SA(0, 0), a2, voffA);
            PG8_WAIT_V(8); PG8_WAIT_L(0); PG8_BAR; PG8_MMA(1, 0, At, B0); PG8_MMA(1, 1, At, B1); PG8_BAR; PG8_SCHED;
            PG8_LDB(B0, 1, 0); PG8_LDB(B1, 1, 1); PG8_SCHED; PG8_LDA(At, 1, 0); PG8_STAGE(PG8_SA(0, 1), a2 + hstep, voffA);
            PG8_WAIT_V(8); PG8_WAIT_L(0); PG8_BAR; PG8_MMA(0, 0, At, B0); PG8_MMA(0, 1, At, B1); PG8_BAR; PG8_SCHED;
            PG8_LDA(At, 1, 1); PG8_STAGE(PG8_SB(1, 0), b3, voffB); PG8_STAGE(PG8_SB(1, 1), b3 + hstep, voffB); PG8_STAGE(PG8_SA(1, 0), a3, voffA);
            PG8_WAIT_V(8); PG8_WAIT_L(0); PG8_BAR; PG8_MMA(1, 0, At, B0); PG8_MMA(1, 1, At, B1); PG8_BAR; PG8_SCHED;
            } else {
            PG8_LDB(B0, 0, 0); PG8_SCHED; PG8_LDA(At, 0, 0); PG8_STAGE(PG8_SA(1, 1), a1 + hstep, voffA);
            PG8_WAIT_L(8); PG8_BAR; PG8_WAIT_L(0); PG8_MMA(0, 0, At, B0); PG8_BAR; PG8_SCHED;
            PG8_LDB(B1, 0, 1); PG8_STAGE(PG8_SB(0, 0), b2, voffB);
            PG8_BAR; PG8_WAIT_L(0); PG8_MMA(0, 1, At, B1); PG8_BAR;
            PG8_LDA(At, 0, 1); PG8_STAGE(PG8_SA(0, 0), a2, voffA);
            PG8_BAR; PG8_WAIT_L(0); PG8_MMA(1, 0, At, B0); PG8_BAR; PG8_SCHED;
            PG8_STAGE(PG8_SB(0, 1), b2 + hstep, voffB);
            PG8_WAIT_V(6); PG8_BAR; PG8_MMA(1, 1, At, B1); PG8_BAR;
            PG8_LDB(B0, 1, 0); PG8_SCHED; PG8_LDA(At, 1, 0); PG8_STAGE(PG8_SA(0, 1), a2 + hstep, voffA);
            PG8_WAIT_L(8); PG8_BAR; PG8_WAIT_L(0); PG8_MMA(0, 0, At, B0); PG8_BAR; PG8_SCHED;
            PG8_LDB(B1, 1, 1); PG8_STAGE(PG8_SB(1, 0), b3, voffB);
            PG8_BAR; PG8_WAIT_L(0); PG8_MMA(0, 1, At, B1); PG8_BAR;
            PG8_LDA(At, 1, 1); PG8_STAGE(PG8_SA(1, 0), a3, voffA);
            PG8_BAR; PG8_WAIT_L(0); PG8_MMA(1, 0, At, B0); PG8_BAR; PG8_SCHED;
            PG8_STAGE(PG8_SB(1, 1), b3 + hstep, voffB);
            PG8_WAIT_V(6); PG8_BAR; PG8_MMA(1, 1, At, B1); PG8_BAR;
            }
        }
        if constexpr (ALIGN_EPI) { if (wr == 0) PG8_BAR; }
        if constexpr (!Epi::AFTER_DRAIN) { E(acc, cur, wr, wc, fr, fq); S.done(cur); }
        if (!has_next) break;
#pragma unroll
        for (int a = 0; a < 2; ++a)
#pragma unroll
            for (int b = 0; b < 2; ++b)
#pragma unroll
                for (int m = 0; m < 4; ++m)
#pragma unroll
                    for (int n = 0; n < 2; ++n) acc[a][b][m][n] = (f32x4){0.f, 0.f, 0.f, 0.f};
        cur = nxt; cA = nA; cB = nB; ++ui;
        if constexpr (ALIGN_EPI) { if (wr == 1) PG8_BAR; }
    }
    PG8_WAIT_V(0);
    if constexpr (!ALIGN_EPI) { if (wr == 0) PG8_BAR; }
    PG8_BAR;
    if constexpr (Epi::AFTER_DRAIN) { E.fused(acc, cur, wr, wc, fr, fq, lds, wid, lane); S.done(cur); }
#undef PG8_SA
#undef PG8_SB
#undef PG8_STAGE
#undef PG8_LDA
#undef PG8_LDB
#undef PG8_MMA
#undef PG8_WAIT_V
#undef PG8_WAIT_L
#undef PG8_BAR
#undef PG8_SCHED
}
}
#define GAS __attribute__((address_space(1)))
#define LAS __attribute__((address_space(3)))
typedef unsigned short bf16;
typedef unsigned v4u __attribute__((ext_vector_type(4)));
typedef float f32x4 __attribute__((ext_vector_type(4)));
typedef short bf16x8 __attribute__((ext_vector_type(8)));
typedef GAS unsigned gu32;
typedef GAS unsigned long long gu64;
#define RLX_AGENT __ATOMIC_RELAXED, __HIP_MEMORY_SCOPE_AGENT
#define LDS_WAIT() asm volatile("s_waitcnt lgkmcnt(0)" ::: "memory")
#define VM_WAIT() asm volatile("s_waitcnt vmcnt(0)" ::: "memory")
__device__ __forceinline__ unsigned long long rt() { return __builtin_amdgcn_s_memrealtime(); }
__device__ __forceinline__ unsigned f2bf(float f) { unsigned u = __builtin_bit_cast(unsigned, f); return (u + 0x7fffu + ((u >> 16) & 1u)) >> 16; }
__device__ __forceinline__ unsigned pk2(float lo, float hi) { return f2bf(lo) | (f2bf(hi) << 16); }

#define XB_TMO      128
#define XB_XCNT(j)  (256  + 64 * (j))
#define XB_XSUB(j)  (1280 + 64 * (j))
#define XB_XGEN(j)  (2304 + 64 * (j))
#define XB_TOP      3328
#define XB_TOPGEN   3392
#define XCD_BAR_WORDS 3456
#define XB_SPIN_CAP (1u << 18)

__device__ __forceinline__ unsigned xb_ld(unsigned* p)              { return __hip_atomic_load(p, __ATOMIC_RELAXED, __HIP_MEMORY_SCOPE_AGENT); }
__device__ __forceinline__ unsigned xb_add(unsigned* p, unsigned v) { return __hip_atomic_fetch_add(p, v, __ATOMIC_RELAXED, __HIP_MEMORY_SCOPE_AGENT); }
__device__ __forceinline__ unsigned xb_xcc_id() { return (unsigned)__builtin_amdgcn_s_getreg((3 << 11) | 20) & 0xFu; }
#define XB_SPIN(cond, bar) do { unsigned _sp = 0; while (cond) { __builtin_amdgcn_s_sleep(1); \
    if ((++_sp & 255u) == 0u) { if (xb_ld(&(bar)[XB_TMO])) break; if (_sp > XB_SPIN_CAP) { atomicAdd(&(bar)[XB_TMO], 1u); break; } } } } while (0)

struct XcdBarrier {
    unsigned* bar; unsigned x;
    volatile LAS unsigned* st;
};

__device__ __forceinline__ XcdBarrier xcd_barrier_post(unsigned* bar, volatile LAS unsigned* st) {
    XcdBarrier b; b.bar = bar; b.x = xb_xcc_id(); b.st = st;
    if (threadIdx.x == 0) (void)xb_add(&bar[XB_XCNT(b.x)], 1u);
    return b;
}
__device__ __forceinline__ void xcd_barrier_complete(unsigned* bar, unsigned x, unsigned& nloc, unsigned& nx) {
    const unsigned G = gridDim.x * gridDim.y * gridDim.z;
    unsigned sum, cnt, mine, sp = 0u;
    for (;;) {
        sum = 0u; cnt = 0u; mine = 0u;
#pragma unroll
        for (unsigned j = 0; j < 16; ++j) { const unsigned c = xb_ld(&bar[XB_XCNT(j)]); sum += c; cnt += (c > 0u) ? 1u : 0u; mine = (j == x) ? c : mine; }
        if (sum == G) break;
        __builtin_amdgcn_s_sleep(1);
        if ((++sp & 255u) == 0u) { if (xb_ld(&bar[XB_TMO])) break; if (sp > XB_SPIN_CAP) { atomicAdd(&bar[XB_TMO], 1u); break; } }
    }
    nloc = mine > 0u ? mine : 1u; nx = cnt > 0u ? cnt : 1u;
}

__device__ __forceinline__ void xcd_barrier(const XcdBarrier& b) {
    asm volatile("s_waitcnt vmcnt(0)" ::: "memory");
    __syncthreads();
    if (threadIdx.x == 0) {
        unsigned* bar = b.bar;
        __builtin_amdgcn_s_waitcnt(0);
        unsigned nloc = b.st[0], nx = b.st[1];
        if (nloc == 0u) { xcd_barrier_complete(bar, b.x, nloc, nx); b.st[0] = nloc; b.st[1] = nx; }
        const unsigned old = xb_add(&bar[XB_XSUB(b.x)], 1u);
        const unsigned gen = old / nloc;
        if (old + 1u == (gen + 1u) * nloc) {
            __builtin_amdgcn_fence(__ATOMIC_RELEASE, "agent");
            asm volatile("s_waitcnt vmcnt(0)" ::: "memory");
            const unsigned og = xb_add(&bar[XB_TOP], 1u);
            const unsigned tg = og / nx;
            if (og + 1u == (tg + 1u) * nx) xb_add(&bar[XB_TOPGEN], 1u);
            else XB_SPIN(xb_ld(&bar[XB_TOPGEN]) == tg, bar);
            __builtin_amdgcn_fence(__ATOMIC_ACQUIRE, "agent");
            xb_add(&bar[XB_XGEN(b.x)], 1u);
            asm volatile("s_waitcnt vmcnt(0)" ::: "memory");
        } else {
            XB_SPIN(xb_ld(&bar[XB_XGEN(b.x)]) == gen, bar);
            __builtin_amdgcn_fence(__ATOMIC_ACQUIRE, "agent");
            asm volatile("s_waitcnt vmcnt(0)" ::: "memory");
        }
    }
    __syncthreads();
}

constexpr int NWAVES = 8, NTHR = 512;
constexpr int T = 16384, D = 1024, SEQ = 4096, NB = 4;
constexpr int FF = 2816, FFE = 3584, NE = 8;
constexpr int NKVQ = 9216;
constexpr float EPS = 1e-6f;
constexpr float QSCALE = 0.125f * 1.4426950408889634f;
constexpr size_t MiB = 1u << 20;
constexpr size_t WS_CTL = 0, CTL_ZERO_BYTES = 1 * MiB;
constexpr size_t WS_TAB = 2 * MiB;
constexpr size_t WS_COS = WS_TAB, WS_SIN = WS_TAB + 512 * 1024, WS_LB = WS_TAB + 1 * MiB, WS_SS0 = WS_LB + 64 * 1024, WS_SS3 = WS_SS0 + 64 * 1024;
constexpr size_t WS_TOKE = WS_TAB + 1 * MiB + 256 * 1024, WS_TOKP = WS_TOKE + 128 * 1024, WS_TOKW = WS_TOKP + 128 * 1024, WS_TOKD = WS_TOKW + 128 * 1024;
constexpr size_t WS_SSS = WS_TOKD + 128 * 1024  , WS_WSORT = WS_TAB + 2 * MiB, WS_DECAY = WS_TAB + 3 * MiB  ;
constexpr size_t WS_SS1 = WS_TAB + 4 * MiB, WS_SS2 = WS_TAB + 5 * MiB;
constexpr size_t WS_QZVG = 8 * MiB;
constexpr size_t WS_KVT = 136 * MiB;
constexpr size_t WS_ST = 200 * MiB;
constexpr size_t WS_OH = 264 * MiB;
constexpr size_t WS_ACTF = 8 * MiB;
constexpr size_t WS_KVQ = 8 * MiB;
constexpr size_t WS_OA = 296 * MiB;
constexpr size_t WS_WGU = 8 * MiB;
constexpr size_t WS_WD = 120 * MiB;
constexpr size_t WS_ASORT = 176 * MiB;
constexpr size_t WS_ACTM = 244 * MiB;
constexpr size_t WS_WS = 400 * MiB;
constexpr size_t WS_WIN = WS_WS, WS_WOH = WS_WIN + 8 * MiB, WS_WFGU = WS_WOH + 2 * MiB, WS_WFD = WS_WFGU + 11 * MiB, WS_WKVQ = WS_WFD + 6 * MiB, WS_WOD = WS_WKVQ + 18 * MiB;
constexpr size_t WS_HB = 448 * MiB;
constexpr size_t WS_END = 482 * MiB;
static_assert(WS_SS2 + 1 * MiB <= WS_QZVG && WS_WOD + 2 * MiB <= WS_HB && WS_ACTM + (size_t)34816 * 3584 * 2 <= WS_END && WS_OA + 32 * MiB <= WS_WS, "ws map");
constexpr int MAXROWS = 34816;

constexpr int CW_TMO = 0, CW_CODE = 1, CW_BAR = 1024, CW_CNT = 8192;

constexpr int RING_OFF = 0, RING_BYTES = 131072;
constexpr int LDSCTL_OFF = RING_BYTES, MISC_OFF = LDSCTL_OFF + 320;
constexpr int LDS_BYTES = 147456;

__device__ __forceinline__ float bf2f(unsigned short b) { return __uint_as_float(((unsigned)b) << 16); }
__device__ __forceinline__ float bflo(unsigned w) { return __uint_as_float(w << 16); }
__device__ __forceinline__ float bfhi(unsigned w) { return __uint_as_float(w & 0xffff0000u); }
__device__ __forceinline__ float wave_sum(float v) {
#pragma unroll
    for (int o = 1; o < 64; o <<= 1) v += __shfl_xor(v, o);
    return v;
}
__device__ __forceinline__ float wave_max(float v) {
#pragma unroll
    for (int o = 1; o < 64; o <<= 1) v = fmaxf(v, __shfl_xor(v, o));
    return v;
}

__device__ __forceinline__ void transpose_item(const float* W, int ldw, int K, const float* gain, bf16* WT, int map, int row_off, LAS float* scr, int kb, int nb, int lane) {
    const int k0 = 64 * kb, n0 = 32 * nb;
#pragma unroll 8
    for (int i = 0; i < 32; ++i) { const int kk = 2 * i + (lane >> 5); const float gk = gain ? gain[k0 + kk] : 1.0f; scr[kk * 33 + (lane & 31)] = W[(size_t)(k0 + kk) * ldw + n0 + (lane & 31)] * gk; }
    LDS_WAIT(); asm volatile("" ::: "memory");
    const int c = lane & 7;
#pragma unroll
    for (int j = 0; j < 4; ++j) { const int n = (lane >> 3) + 8 * j; const LAS float* s = scr + (8 * c) * 33 + n;
        v4u o; o.x = pk2(s[0 * 33], s[1 * 33]); o.y = pk2(s[2 * 33], s[3 * 33]); o.z = pk2(s[4 * 33], s[5 * 33]); o.w = pk2(s[6 * 33], s[7 * 33]);
        const int nn = n0 + n; int dr = nn;
        if (map == 1) dr = ((nn >> 7) << 8) + (nn & 127);
        if (map == 2) { const int d = nn & 63; dr = (nn & ~63) + 8 * ((d & 31) >> 2) + 4 * (d >> 5) + (d & 3); }
        *(GAS v4u*)(WT + (size_t)(row_off + dr) * K + k0 + 8 * c) = o; }
    LDS_WAIT(); asm volatile("" ::: "memory");
}

struct Args { const float* in[19]; float* out; unsigned char* ws; int ph_lo, ph_hi; };
constexpr int NPHASE = 16;

__global__ void __launch_bounds__(NTHR, 2) fwd_kernel(Args args) {
    extern __shared__ __attribute__((aligned(16))) unsigned char lds_raw[];
    LAS unsigned char* lds = (LAS unsigned char*)lds_raw;
    volatile LAS unsigned* MISC = (volatile LAS unsigned*)(lds + MISC_OFF);
    const int tid = threadIdx.x, lane = tid & 63, wave = __builtin_amdgcn_readfirstlane(tid >> 6);
    const int G = gridDim.x, bid = blockIdx.x;
    const int gw = bid * NWAVES + wave, NGW = G * NWAVES;
    unsigned char* ws = args.ws;
    gu32* ctl = (gu32*)(ws + WS_CTL);
    const int lo = args.ph_lo, hi = args.ph_hi;
    for (int u = tid; u < (LDS_BYTES - LDSCTL_OFF) / 4; u += NTHR) ((LAS unsigned*)(lds + LDSCTL_OFF))[u] = 0u;
    __syncthreads();
    XcdBarrier bar; bar.bar = (unsigned*)(ctl + CW_BAR); bar.x = 0; bar.st = nullptr;
    if (hi - lo > 1) bar = xcd_barrier_post((unsigned*)(ctl + CW_BAR), MISC + 8);
#define IN(k) (lo <= (k) && (k) < hi)
#define SEAM(k) do { if (IN(k) && IN((k) + 1)) xcd_barrier(bar); } while (0)

    const float* x = args.in[0]; const float* attn_norm = args.in[1]; const float* ffn_norm = args.in[2]; const float* hgrn_w_in = args.in[3];
    const float* hgrn_lb = args.in[4]; const float* hgrn_onorm = args.in[5]; const float* hgrn_w_out = args.in[6]; const float* kv_norm = args.in[7];
    const float* w_kv = args.in[8]; const float* dil_w_q = args.in[9]; const float* dil_w_out = args.in[10]; const float* ffn_wg = args.in[11];
    const float* ffn_wu = args.in[12]; const float* ffn_wd = args.in[13]; const float* moe_wr = args.in[14]; const float* moe_wg = args.in[15];
    const float* moe_wu = args.in[16]; const float* moe_wd = args.in[17]; const float* final_norm = args.in[18];
    float* hf = args.out;
    bf16* hb = (bf16*)(ws + WS_HB);
    float* cosT = (float*)(ws + WS_COS); float* sinT = (float*)(ws + WS_SIN); float* lbv = (float*)(ws + WS_LB);
    float* ss0 = (float*)(ws + WS_SS0); float* ss1 = (float*)(ws + WS_SS1); float* ss2 = (float*)(ws + WS_SS2); float* ss3 = (float*)(ws + WS_SS3);
    bf16* W_in = (bf16*)(ws + WS_WIN); bf16* W_oh = (bf16*)(ws + WS_WOH); bf16* W_fgu = (bf16*)(ws + WS_WFGU); bf16* W_fd = (bf16*)(ws + WS_WFD);
    bf16* W_kvq = (bf16*)(ws + WS_WKVQ); bf16* W_od = (bf16*)(ws + WS_WOD); bf16* W_gu = (bf16*)(ws + WS_WGU); bf16* W_d = (bf16*)(ws + WS_WD);
    bf16* qzvg = (bf16*)(ws + WS_QZVG); bf16* kvT = (bf16*)(ws + WS_KVT); bf16* stT = (bf16*)(ws + WS_ST); bf16* oh = (bf16*)(ws + WS_OH);
    bf16* actf = (bf16*)(ws + WS_ACTF); bf16* kvq = (bf16*)(ws + WS_KVQ); bf16* oa = (bf16*)(ws + WS_OA);
    bf16* asort = (bf16*)(ws + WS_ASORT); bf16* actm = (bf16*)(ws + WS_ACTM);
    float* decay = (float*)(ws + WS_DECAY);
    int* tok_e = (int*)(ws + WS_TOKE); int* tok_p = (int*)(ws + WS_TOKP); float* tok_w = (float*)(ws + WS_TOKW); int* tok_d = (int*)(ws + WS_TOKD);
    float* ss_sorted = (float*)(ws + WS_SSS); float* w_sorted = (float*)(ws + WS_WSORT);

    if (IN(0)) {
        LAS float* scr = (LAS float*)(lds + RING_OFF + wave * 16384);
        constexpr int I_IN = 16 * 128, I_OH = 16 * 32, I_FG = 16 * 88, I_FD = 44 * 32, I_KV = 16 * 96;
        constexpr int NIT = I_IN + I_OH + 2 * I_FG + I_FD + 3 * I_KV + I_OH;
        for (int it = gw; it < NIT; it += NGW) {
            int r = it;
            if (r < I_IN) { transpose_item(hgrn_w_in, 4096, 1024, attn_norm, W_in, 0, 0, scr, r / 128, r % 128, lane); continue; } r -= I_IN;
            if (r < I_OH) { transpose_item(hgrn_w_out, 1024, 1024, nullptr, W_oh, 0, 0, scr, r / 32, r % 32, lane); continue; } r -= I_OH;
            if (r < I_FG) { transpose_item(ffn_wg, FF, 1024, ffn_norm, W_fgu, 1, 0, scr, r / 88, r % 88, lane); continue; } r -= I_FG;
            if (r < I_FG) { transpose_item(ffn_wu, FF, 1024, ffn_norm, W_fgu, 1, 128, scr, r / 88, r % 88, lane); continue; } r -= I_FG;
            if (r < I_FD) { transpose_item(ffn_wd, 1024, FF, nullptr, W_fd, 0, 0, scr, r / 32, r % 32, lane); continue; } r -= I_FD;
            if (r < I_KV) { transpose_item(w_kv, 6144, 1024, kv_norm, W_kvq, 2, 0, scr, r / 96, r % 96, lane); continue; } r -= I_KV;
            if (r < I_KV) { transpose_item(w_kv + 3072, 6144, 1024, kv_norm, W_kvq, 0, 3072, scr, r / 96, r % 96, lane); continue; } r -= I_KV;
            if (r < I_KV) { transpose_item(dil_w_q, 3072, 1024, attn_norm + 1024, W_kvq, 2, 6144, scr, r / 96, r % 96, lane); continue; } r -= I_KV;
            transpose_item(dil_w_out, 1024, 1024, nullptr, W_od, 0, 0, scr, r / 32, r % 32, lane);
        }
        for (int m = gw; m < T; m += NGW) {
            const GAS f32x4* xr = (const GAS f32x4*)(x + (size_t)m * D) + lane; f32x4 v[4]; float s = 0.f;
#pragma unroll
            for (int j = 0; j < 4; ++j) { v[j] = xr[64 * j]; s += (v[j].x * v[j].x + v[j].y * v[j].y) + (v[j].z * v[j].z + v[j].w * v[j].w); }
            s = wave_sum(s);
            GAS unsigned long long* o8 = (GAS unsigned long long*)(hb + (size_t)m * D) + lane;
#pragma unroll
            for (int j = 0; j < 4; ++j) o8[64 * j] = (unsigned long long)pk2(v[j].x, v[j].y) | ((unsigned long long)pk2(v[j].z, v[j].w) << 32);
            if (lane == 0) ss0[m] = s;
        }
        for (int i = bid * NTHR + tid; i < SEQ * 32; i += G * NTHR) {
            const int pos = i >> 5, j = i & 31;
            const float inv = (float)exp2(-(double)j * (13.287712379549449 / 32.0));
            const float ang = (float)pos * inv;
            const double rev = (double)ang * 0.15915494309189535; const float fr = (float)(rev - floor(rev));
            cosT[i] = __builtin_amdgcn_cosf(fr); sinT[i] = __builtin_amdgcn_sinf(fr);
        }
        for (int i = bid * NTHR + tid; i < 1024; i += G * NTHR) lbv[i] = 1.0f / (1.0f + __expf(hgrn_lb[1024 + i] - hgrn_lb[i]));
    }
    SEAM(0);

    if (IN(1)) {
        pg8::Gemm g{hb, W_in, T, 4096, 1024}; pg8::StaticOrder S; S.init(T, 4096, G, bid);
        pg8::EpiScale<0> E{qzvg, 4096, ss0, nullptr, nullptr, 1.f};
        pg8::gemm_phase<pg8::EpiScale<0>, pg8::StaticOrder, true, true>(lds + RING_OFF, g, S, E);
    }
    SEAM(1);

    if (IN(2)) {
        LAS float* kE = (LAS float*)(lds);
        LAS float* vS = (LAS float*)(lds + 32768);
        LAS float* tot = (LAS float*)(lds + 65536);
        const int dp = tid & 63, seg = tid >> 6;
        for (int unit = bid; unit < 2048; unit += G) {
            const int b = unit >> 9, h = (unit >> 6) & 7, c = unit & 63; const size_t r0 = (size_t)b * SEQ + c * 64;
            const int d0 = 2 * dp; const float lb0 = lbv[h * 128 + d0], lb1 = lbv[h * 128 + d0 + 1];
            float bl0[8], bl1[8], k0[8], k1[8]; float run0 = 0.f, run1 = 0.f;
#pragma unroll
            for (int i = 0; i < 8; ++i) { const int t = 8 * seg + i; const bf16* rp = qzvg + (r0 + t) * 4096 + h * 128 + d0;
                const unsigned zz = *(const unsigned*)(rp + 1024), vv = *(const unsigned*)(rp + 2048);
                const float f0 = lb0 + (1.f - lb0) / (1.f + __expf(-bflo(zz))), f1 = lb1 + (1.f - lb1) / (1.f + __expf(-bfhi(zz)));
                run0 += __logf(f0); run1 += __logf(f1); bl0[i] = run0; bl1[i] = run1; k0[i] = 1.f - f0; k1[i] = 1.f - f1;
                vS[t * 128 + d0] = bflo(vv); vS[t * 128 + d0 + 1] = bfhi(vv); }
            tot[seg * 128 + d0] = run0; tot[seg * 128 + d0 + 1] = run1;
            __syncthreads();
            float pre0 = 0.f, pre1 = 0.f, all0 = 0.f, all1 = 0.f;
#pragma unroll
            for (int s = 0; s < 8; ++s) { const float a = tot[s * 128 + d0], bq = tot[s * 128 + d0 + 1]; all0 += a; all1 += bq; if (s < seg) { pre0 += a; pre1 += bq; } }
#pragma unroll
            for (int i = 0; i < 8; ++i) { const int t = 8 * seg + i; kE[t * 128 + d0] = k0[i] * __expf(all0 - (pre0 + bl0[i])); kE[t * 128 + d0 + 1] = k1[i] * __expf(all1 - (pre1 + bl1[i])); }
            if (seg == 0) { decay[unit * 128 + d0] = __expf(all0); decay[unit * 128 + d0 + 1] = __expf(all1); }
            __syncthreads();
            const int dg = tid & 31, vg = tid >> 5;
            float acc[8][4];
#pragma unroll
            for (int j = 0; j < 8; ++j)
#pragma unroll
                for (int i = 0; i < 4; ++i) acc[j][i] = 0.f;
            for (int s = 0; s < 64; ++s) {
                const f32x4 k4 = *(const LAS f32x4*)(kE + s * 128 + 4 * dg); const f32x4 va = *(const LAS f32x4*)(vS + s * 128 + 8 * vg), vb = *(const LAS f32x4*)(vS + s * 128 + 8 * vg + 4);
#pragma unroll
                for (int j = 0; j < 4; ++j)
#pragma unroll
                    for (int i = 0; i < 4; ++i) { acc[j][i] += va[j] * k4[i]; acc[j + 4][i] += vb[j] * k4[i]; }
            }
#pragma unroll
            for (int j = 0; j < 8; ++j) *(unsigned long long*)(kvT + ((size_t)unit * 128 + 8 * vg + j) * 128 + 4 * dg) = (unsigned long long)pk2(acc[j][0], acc[j][1]) | ((unsigned long long)pk2(acc[j][2], acc[j][3]) << 32);
            __syncthreads();
        }
    }
    SEAM(2);

    if (IN(3)) {
        for (int idx = bid * NTHR + tid; idx < 32 * 128 * 32; idx += G * NTHR) {
            const int bh = idx >> 12, v = (idx >> 5) & 127, dg = idx & 31;
            f32x4 st = (f32x4){0.f, 0.f, 0.f, 0.f};
#pragma unroll 8
            for (int c = 0; c < 64; ++c) { const size_t unit = (size_t)bh * 64 + c; const size_t o = (unit * 128 + v) * 128 + 4 * dg;
                *(unsigned long long*)(stT + o) = (unsigned long long)pk2(st[0], st[1]) | ((unsigned long long)pk2(st[2], st[3]) << 32);
                const f32x4 dc = *(const f32x4*)(decay + unit * 128 + 4 * dg); const unsigned long long kv = *(const unsigned long long*)(kvT + o);
                const unsigned klo = (unsigned)kv, khi = (unsigned)(kv >> 32);
                st[0] = dc[0] * st[0] + bflo(klo); st[1] = dc[1] * st[1] + bfhi(klo); st[2] = dc[2] * st[2] + bflo(khi); st[3] = dc[3] * st[3] + bfhi(khi); }
        }
    }
    SEAM(3);

    if (IN(4)) {
        LAS float* qd = (LAS float*)(lds);
        LAS float* kd = (LAS float*)(lds + 33280);
        LAS float* vS = (LAS float*)(lds + 66560);
        LAS float* sc = (LAS float*)(lds + 99328);
        LAS float* tot = (LAS float*)(lds + 116224);
        LAS bf16* stI = (LAS bf16*)(lds + 33280);
        const int dp = tid & 63, seg = tid >> 6;
        for (int unit = bid; unit < 2048; unit += G) {
            const int b = unit >> 9, h = (unit >> 6) & 7, c = unit & 63; const size_t r0 = (size_t)b * SEQ + c * 64;
            const int d0 = 2 * dp; const float lb0 = lbv[h * 128 + d0], lb1 = lbv[h * 128 + d0 + 1];
            float bl0[8], bl1[8], k0[8], k1[8], q0[8], q1[8]; float run0 = 0.f, run1 = 0.f;
#pragma unroll
            for (int i = 0; i < 8; ++i) { const int t = 8 * seg + i; const bf16* rp = qzvg + (r0 + t) * 4096 + h * 128 + d0;
                const unsigned qq = *(const unsigned*)(rp), zz = *(const unsigned*)(rp + 1024), vv = *(const unsigned*)(rp + 2048);
                const float f0 = lb0 + (1.f - lb0) / (1.f + __expf(-bflo(zz))), f1 = lb1 + (1.f - lb1) / (1.f + __expf(-bfhi(zz)));
                run0 += __logf(f0); run1 += __logf(f1); bl0[i] = run0; bl1[i] = run1; k0[i] = 1.f - f0; k1[i] = 1.f - f1; q0[i] = bflo(qq); q1[i] = bfhi(qq);
                vS[t * 128 + d0] = bflo(vv); vS[t * 128 + d0 + 1] = bfhi(vv); }
            tot[seg * 128 + d0] = run0; tot[seg * 128 + d0 + 1] = run1;
            __syncthreads();
            float pre0 = 0.f, pre1 = 0.f;
#pragma unroll
            for (int s = 0; s < 8; ++s) { if (s < seg) { pre0 += tot[s * 128 + d0]; pre1 += tot[s * 128 + d0 + 1]; } }
#pragma unroll
            for (int i = 0; i < 8; ++i) { const int t = 8 * seg + i; const float b0 = pre0 + bl0[i], b1 = pre1 + bl1[i];
                qd[t * 129 + d0] = q0[i] * __expf(b0); qd[t * 129 + d0 + 1] = q1[i] * __expf(b1);
                kd[t * 129 + d0] = k0[i] * __expf(-b0); kd[t * 129 + d0 + 1] = k1[i] * __expf(-b1); }
            __syncthreads();
            {
                const int t = tid >> 3, sg = tid & 7; float a[8];
#pragma unroll
                for (int j = 0; j < 8; ++j) a[j] = 0.f;
                for (int d = 0; d < 128; ++d) { const float qv = qd[t * 129 + d];
#pragma unroll
                    for (int j = 0; j < 8; ++j) a[j] += qv * kd[(sg + 8 * j) * 129 + d]; }
#pragma unroll
                for (int j = 0; j < 8; ++j) { const int s = sg + 8 * j; sc[t * 65 + s] = (s <= t) ? a[j] : 0.f; }
            }
            __syncthreads();
            {
                const bf16* sp = stT + (size_t)unit * 16384;
                for (int i = tid; i < 128 * 64; i += NTHR) { const int v = i >> 6, d2 = i & 63; *(LAS unsigned*)(stI + v * 130 + 2 * d2) = *(const unsigned*)(sp + v * 128 + 2 * d2); }
            }
            __syncthreads();
            {
                const int t = tid >> 3, vg = tid & 7; float o[16];
#pragma unroll
                for (int j = 0; j < 16; ++j) o[j] = 0.f;
                for (int s = 0; s < 64; ++s) { const float p = sc[t * 65 + s];
#pragma unroll
                    for (int j = 0; j < 16; ++j) o[j] += p * vS[s * 128 + vg + 8 * j]; }
                for (int d2 = 0; d2 < 64; ++d2) { const float qa = qd[t * 129 + 2 * d2], qb = qd[t * 129 + 2 * d2 + 1];
#pragma unroll
                    for (int j = 0; j < 16; ++j) { const unsigned w = *(const LAS unsigned*)(stI + (vg + 8 * j) * 130 + 2 * d2); o[j] += qa * bflo(w) + qb * bfhi(w); } }
                float ssq = 0.f;
#pragma unroll
                for (int j = 0; j < 16; ++j) ssq += o[j] * o[j];
                ssq += __shfl_xor(ssq, 1); ssq += __shfl_xor(ssq, 2); ssq += __shfl_xor(ssq, 4);
                const float r = __builtin_amdgcn_rsqf(ssq * (1.f / 128.f) + EPS);
                const bf16* gp = qzvg + (r0 + t) * 4096 + 3072 + h * 128; bf16* op = oh + (r0 + t) * 1024 + h * 128;
#pragma unroll
                for (int j = 0; j < 16; ++j) { const int v = vg + 8 * j; const float gv = bf2f(gp[v]); const float y = o[j] * r * hgrn_onorm[v] * (gv / (1.f + __expf(-gv))); op[v] = (bf16)f2bf(y); }
            }
            __syncthreads();
        }
    }
    SEAM(4);

    if (IN(5)) {
        pg8::Gemm g{oh, W_oh, T, 1024, 1024}; pg8::StaticOrder S; S.init(T, 1024, G, bid);
        pg8::EpiResid<true> E{x, hf, hb, ss1};
        pg8::gemm_phase<pg8::EpiResid<true>, pg8::StaticOrder, true, true>(lds + RING_OFF, g, S, E);
    }
    SEAM(5);

    if (IN(6)) {
        pg8::Gemm g{hb, W_fgu, T, 2 * FF, 1024}; pg8::StaticOrder S; S.init(T, 2 * FF, G, bid);
        pg8::EpiSwiglu<true> E{actf, FF, ss1, 22};
        pg8::gemm_phase<pg8::EpiSwiglu<true>, pg8::StaticOrder, true, true>(lds + RING_OFF, g, S, E);
    }
    SEAM(6);

    if (IN(7)) {
        pg8::Gemm g{actf, W_fd, T, 1024, FF}; pg8::StaticOrder S; S.init(T, 1024, G, bid);
        pg8::EpiResid<true> E{hf, hf, hb, ss2};
        pg8::gemm_phase<pg8::EpiResid<true>, pg8::StaticOrder, true, true>(lds + RING_OFF, g, S, E);
    }
    SEAM(7);

    if (IN(8)) {
        pg8::Gemm g{hb, W_kvq, T, NKVQ, 1024}; pg8::StaticOrder S; S.init(T, NKVQ, G, bid);
        pg8::EpiScale<1> E{kvq, NKVQ, ss2, cosT, sinT, QSCALE};
        pg8::gemm_phase<pg8::EpiScale<1>, pg8::StaticOrder, true, true>(lds + RING_OFF, g, S, E);
    }
    SEAM(8);

    if (IN(9)) {
        for (int pair = gw; pair < T * 16; pair += NGW) {
            const int t = pair >> 4, h = pair & 15, sp = t & (SEQ - 1);
            float scv[3][3];
#pragma unroll
            for (int br = 0; br < 3; ++br) { const int dil = br == 0 ? 1 : (br == 1 ? 4 : 16);
                const bf16* qp = kvq + (size_t)t * NKVQ + 6144 + br * 1024 + h * 64;
                unsigned qw[32];
#pragma unroll
                for (int i = 0; i < 8; ++i) { const v4u q4 = *(const v4u*)(qp + 8 * i); qw[4 * i] = q4.x; qw[4 * i + 1] = q4.y; qw[4 * i + 2] = q4.z; qw[4 * i + 3] = q4.w; }
#pragma unroll
                for (int r = 0; r < 3; ++r) { const int j = lane + 64 * r; const bool valid = (j <= 128) && (sp - j * dil >= 0);
                    float dot = 0.f;
                    if (valid) { const bf16* kp = kvq + (size_t)(t - j * dil) * NKVQ + br * 1024 + h * 64;
#pragma unroll
                        for (int i = 0; i < 8; ++i) { const v4u k4 = *(const v4u*)(kp + 8 * i);
                            dot += bflo(qw[4 * i]) * bflo(k4.x) + bfhi(qw[4 * i]) * bfhi(k4.x) + bflo(qw[4 * i + 1]) * bflo(k4.y) + bfhi(qw[4 * i + 1]) * bfhi(k4.y)
                                 + bflo(qw[4 * i + 2]) * bflo(k4.z) + bfhi(qw[4 * i + 2]) * bfhi(k4.z) + bflo(qw[4 * i + 3]) * bflo(k4.w) + bfhi(qw[4 * i + 3]) * bfhi(k4.w); } }
                    scv[br][r] = valid ? dot : -INFINITY; } }
            float mx = -INFINITY;
#pragma unroll
            for (int br = 0; br < 3; ++br)
#pragma unroll
                for (int r = 0; r < 3; ++r) mx = fmaxf(mx, scv[br][r]);
            mx = wave_max(mx);
            float lsum = 0.f;
#pragma unroll
            for (int br = 0; br < 3; ++br)
#pragma unroll
                for (int r = 0; r < 3; ++r) { scv[br][r] = __builtin_amdgcn_exp2f(scv[br][r] - mx); lsum += scv[br][r]; }
            lsum = wave_sum(lsum);
            float acc = 0.f;
#pragma unroll
            for (int br = 0; br < 3; ++br) { const int dil = br == 0 ? 1 : (br == 1 ? 4 : 16);
                const bf16* vp = kvq + 3072 + br * 1024 + h * 64 + lane;
#pragma unroll
                for (int r = 0; r < 3; ++r) { const int nj = r < 2 ? 64 : 1;
                    for (int jj = 0; jj < nj; ++jj) { const int j = jj + 64 * r; if (sp - j * dil < 0) break;
                        const float pj = __shfl(scv[br][r], jj); acc += pj * bf2f(vp[(size_t)(t - j * dil) * NKVQ]); } } }
            oa[(size_t)t * 1024 + h * 64 + lane] = (bf16)f2bf(acc / lsum);
        }
    }
    SEAM(9);

    if (IN(10)) {
        pg8::Gemm g{oa, W_od, T, 1024, 1024}; pg8::StaticOrder S; S.init(T, 1024, G, bid);
        pg8::EpiResid<false> E{hf, hf, hb, nullptr};
        pg8::gemm_phase<pg8::EpiResid<false>, pg8::StaticOrder, true, true>(lds + RING_OFF, g, S, E);
    }
    SEAM(10);

    if (IN(11)) {
        const float* gain = ffn_norm + 1024;
        for (int t = gw; t < T; t += NGW) {
            const GAS f32x4* hr = (const GAS f32x4*)(hf + (size_t)t * D) + lane; f32x4 v[4]; float s = 0.f;
#pragma unroll
            for (int j = 0; j < 4; ++j) { v[j] = hr[64 * j]; s += (v[j].x * v[j].x + v[j].y * v[j].y) + (v[j].z * v[j].z + v[j].w * v[j].w); }
            s = wave_sum(s);
            const float rstd = __builtin_amdgcn_rsqf(s * (1.f / 1024.f) + EPS);
            float lg[8];
#pragma unroll
            for (int e = 0; e < 8; ++e) lg[e] = 0.f;
#pragma unroll
            for (int j = 0; j < 4; ++j)
#pragma unroll
                for (int i = 0; i < 4; ++i) { const int k = 4 * (lane + 64 * j) + i; const float xv = v[j][i] * gain[k];
                    const f32x4 w0 = *(const f32x4*)(moe_wr + k * 8), w1 = *(const f32x4*)(moe_wr + k * 8 + 4);
                    lg[0] += xv * w0[0]; lg[1] += xv * w0[1]; lg[2] += xv * w0[2]; lg[3] += xv * w0[3]; lg[4] += xv * w1[0]; lg[5] += xv * w1[1]; lg[6] += xv * w1[2]; lg[7] += xv * w1[3]; }
#pragma unroll
            for (int e = 0; e < 8; ++e) lg[e] = wave_sum(lg[e]) * rstd;
            int e1 = 0; float m1 = lg[0];
#pragma unroll
            for (int e = 1; e < 8; ++e) if (lg[e] > m1) { m1 = lg[e]; e1 = e; }
            int e2 = -1; float m2 = -INFINITY;
#pragma unroll
            for (int e = 0; e < 8; ++e) if (e != e1 && lg[e] > m2) { m2 = lg[e]; e2 = e; }
            const float p2 = __expf(m2 - m1); const float w1v = 1.f / (1.f + p2), w2v = p2 / (1.f + p2);
            if (lane == 0) { const unsigned pa = atomicAdd((unsigned*)(ctl + CW_CNT + 64 * e1), 1u), pb = atomicAdd((unsigned*)(ctl + CW_CNT + 64 * e2), 1u);
                tok_e[2 * t] = e1; tok_e[2 * t + 1] = e2; tok_p[2 * t] = (int)pa; tok_p[2 * t + 1] = (int)pb; tok_w[2 * t] = w1v; tok_w[2 * t + 1] = w2v; ss3[t] = s; }
        }
        LAS float* scr = (LAS float*)(lds + RING_OFF + wave * 16384);
        constexpr int I_G = 16 * 112, I_D = 56 * 32, I_E = 2 * I_G + I_D;
        for (int it = gw; it < NE * I_E; it += NGW) {
            const int e = it / I_E; int r = it - e * I_E;
            if (r < I_G) { transpose_item(moe_wg + (size_t)e * 1024 * FFE, FFE, 1024, gain, W_gu + (size_t)e * 7168 * 1024, 1, 0, scr, r / 112, r % 112, lane); continue; } r -= I_G;
            if (r < I_G) { transpose_item(moe_wu + (size_t)e * 1024 * FFE, FFE, 1024, gain, W_gu + (size_t)e * 7168 * 1024, 1, 128, scr, r / 112, r % 112, lane); continue; } r -= I_G;
            transpose_item(moe_wd + (size_t)e * FFE * 1024, 1024, FFE, nullptr, W_d + (size_t)e * 1024 * FFE, 0, 0, scr, r / 32, r % 32, lane);
        }
    }
    SEAM(11);

    int tp1 = 0, tp2 = 0, tp3 = 0, tp4 = 0, tp5 = 0, tp6 = 0, tp7 = 0, tp8 = 0;
    if (hi > 12 && lo <= 14) {
        int c[8];
#pragma unroll
        for (int e = 0; e < 8; ++e) c[e] = (int)((__hip_atomic_load(ctl + CW_CNT + 64 * e, RLX_AGENT) + 255u) >> 8);
        tp1 = c[0]; tp2 = tp1 + c[1]; tp3 = tp2 + c[2]; tp4 = tp3 + c[3]; tp5 = tp4 + c[4]; tp6 = tp5 + c[5]; tp7 = tp6 + c[6]; tp8 = tp7 + c[7];
    }

    if (IN(12)) {
        for (int t = gw; t < T; t += NGW) {
#pragma unroll
            for (int k = 0; k < 2; ++k) { const int e = tok_e[2 * t + k];
                const int tb = e == 0 ? 0 : e == 1 ? tp1 : e == 2 ? tp2 : e == 3 ? tp3 : e == 4 ? tp4 : e == 5 ? tp5 : e == 6 ? tp6 : tp7;
                const int dst = tb * 256 + tok_p[2 * t + k];
                const v4u* src = (const v4u*)(hb + (size_t)t * D); v4u* dp = (v4u*)(asort + (size_t)dst * D);
                dp[lane] = src[lane]; dp[lane + 64] = src[lane + 64];
                if (lane == 0) { ss_sorted[dst] = ss3[t]; w_sorted[dst] = tok_w[2 * t + k]; tok_d[2 * t + k] = dst; } }
        }
    }
    SEAM(12);

    if (IN(13)) {
        pg8::Gemm g{asort, W_gu, tp8 * 256, 7168, 1024};
        pg8::MoeOrder S{tp8, 28, tp8 * 28, G, bid, tp1, tp2, tp3, tp4, tp5, tp6, tp7};
        pg8::EpiSwiglu<false> E{actm, FFE, ss_sorted, 28};
        pg8::gemm_phase<pg8::EpiSwiglu<false>, pg8::MoeOrder, true, true>(lds + RING_OFF, g, S, E);
    }
    SEAM(13);

    if (IN(14)) {
        pg8::Gemm g{actm, W_d, tp8 * 256, 1024, FFE};
        pg8::MoeOrder S{tp8, 4, tp8 * 4, G, bid, tp1, tp2, tp3, tp4, tp5, tp6, tp7};
        pg8::EpiDownMoe E{asort, w_sorted};
        pg8::gemm_phase<pg8::EpiDownMoe, pg8::MoeOrder, true, true>(lds + RING_OFF, g, S, E);
    }
    SEAM(14);

    if (IN(15)) {
        for (int t = gw; t < T; t += NGW) {
            const int d0 = tok_d[2 * t], d1 = tok_d[2 * t + 1];
            GAS f32x4* hr = (GAS f32x4*)(hf + (size_t)t * D) + lane;
            const GAS unsigned long long* y0 = (const GAS unsigned long long*)(asort + (size_t)d0 * D) + lane; const GAS unsigned long long* y1 = (const GAS unsigned long long*)(asort + (size_t)d1 * D) + lane;
            f32x4 v[4]; float s = 0.f;
#pragma unroll
            for (int j = 0; j < 4; ++j) { v[j] = hr[64 * j]; const unsigned long long a = y0[64 * j], bq = y1[64 * j];
                v[j].x += bflo((unsigned)a) + bflo((unsigned)bq); v[j].y += bfhi((unsigned)a) + bfhi((unsigned)bq);
                v[j].z += bflo((unsigned)(a >> 32)) + bflo((unsigned)(bq >> 32)); v[j].w += bfhi((unsigned)(a >> 32)) + bfhi((unsigned)(bq >> 32));
                s += (v[j].x * v[j].x + v[j].y * v[j].y) + (v[j].z * v[j].z + v[j].w * v[j].w); }
            s = wave_sum(s);
            const float rstd = __builtin_amdgcn_rsqf(s * (1.f / 1024.f) + EPS);
#pragma unroll
            for (int j = 0; j < 4; ++j) { const f32x4 gn = *((const GAS f32x4*)final_norm + lane + 64 * j); hr[64 * j] = v[j] * rstd * gn; }
        }
    }
#undef IN
#undef SEAM
}

#ifndef MK_N_LAUNCHES
#define MK_N_LAUNCHES 1
#endif
extern "C" void kernel_launch(void* const* d_in, const int* in_sizes, int n_in, void* d_out, int out_size, void* d_ws, size_t ws_size, hipStream_t stream) {
    static int grid = 0;
    if (grid == 0) {
        if (n_in != 19 || in_sizes[0] != T * D || out_size != T * D || ws_size < WS_END) { fprintf(stderr, "kernel_launch: unexpected shapes / workspace (n_in %d, ws %zu); nothing launched\n", n_in, ws_size); grid = -1; return; }
        int dev = 0, cus = 0, per_cu = 0;
        if (hipGetDevice(&dev) != hipSuccess || hipDeviceGetAttribute(&cus, hipDeviceAttributeMultiprocessorCount, dev) != hipSuccess) { grid = -1; return; }
        if (hipFuncSetAttribute((const void*)fwd_kernel, hipFuncAttributeMaxDynamicSharedMemorySize, LDS_BYTES) != hipSuccess) { fprintf(stderr, "kernel_launch: hipFuncSetAttribute failed\n"); grid = -1; return; }
        if (hipOccupancyMaxActiveBlocksPerMultiprocessor(&per_cu, (const void*)fwd_kernel, NTHR, LDS_BYTES) != hipSuccess || per_cu < 1) { fprintf(stderr, "kernel_launch: occupancy query reports %d\n", per_cu); }
        (void)hipGetLastError();
        grid = cus;
    }
    if (grid < 0) return;
    if (hipMemsetAsync((char*)d_ws + WS_CTL, 0, CTL_ZERO_BYTES, stream) != hipSuccess) return;
    Args a{};
    for (int i = 0; i < 19; ++i) a.in[i] = (const float*)d_in[i];
    a.out = (float*)d_out; a.ws = (unsigned char*)d_ws;
    if (MK_N_LAUNCHES == 1) { a.ph_lo = 0; a.ph_hi = NPHASE; hipLaunchKernelGGL(fwd_kernel, dim3(grid), dim3(NTHR), LDS_BYTES, stream, a); }
    else for (int p = 0; p < NPHASE; ++p) { a.ph_lo = p; a.ph_hi = p + 1; hipLaunchKernelGGL(fwd_kernel, dim3(grid), dim3(NTHR), LDS_BYTES, stream, a); }
}
```

```cpp
#include <hip/hip_runtime.h>
#include <cstdio>
#include <cstdint>
#include <cmath>
namespace pg8 {
#define PG8_LAS __attribute__((address_space(3)))
typedef unsigned short bf16_t;
typedef short bf16x8 __attribute__((ext_vector_type(8)));
typedef float f32x4 __attribute__((ext_vector_type(4)));
typedef unsigned u32x4 __attribute__((ext_vector_type(4)));
typedef int v4i_t __attribute__((ext_vector_type(4)));
typedef int v8i_t __attribute__((ext_vector_type(8)));
typedef float f32x2 __attribute__((ext_vector_type(2)));
constexpr int BM = 256, BK = 64, HALF = 128, HTB = HALF * BK * 2  , STAGE_BYTES = 8 * HTB, NXCD = 8, WGM = 8;

__host__ __device__ __forceinline__ int lds_byte(int r, int c) { const int st = (r >> 4) * 2 + (c >> 5), rr = r & 15, cc = c & 31, ob = rr * 64 + cc * 2; return st * 1024 + (ob ^ (((ob >> 9) & 1) << 5)); }
__host__ __device__ __forceinline__ void stage_rc(int b, int& R, int& C) { const int st = b / 1024, sb = b % 1024, swz = sb ^ (((sb >> 9) & 1) << 5); R = (st >> 1) * 16 + swz / 64; C = (st & 1) * 32 + (swz % 64) / 2; }
__host__ __device__ __forceinline__ int perm32(int rho) { const int n = rho >> 4, i = rho & 15; return 8 * (i >> 2) + 4 * n + (i & 3); }

struct Unit { int pm, pn, ks; };
struct Gemm { const bf16_t* A; const bf16_t* Bt; int M, N, K; int nt; };

struct StaticOrder {
    int nM, nN, nwg, G, c;
    __host__ __device__ __forceinline__ void init(int M, int N, int G_, int c_) { nM = M / BM; nN = N / BM; nwg = nM * nN; G = G_; c = c_; }
    __host__ __device__ __forceinline__ bool next(int i, Unit& u) const {
        const long L = (long)i * G + c; if (L >= nwg) return false;
        int wgid = (int)L; { const int q = nwg / NXCD, r = nwg % NXCD, xcd = wgid % NXCD, off = wgid / NXCD; wgid = (xcd < r ? xcd * (q + 1) : r * (q + 1) + (xcd - r) * q) + off; }
        const int nig = WGM * nN, gid = wgid / nig, fm = gid * WGM, gsz = (nM - fm) < WGM ? (nM - fm) : WGM;
        u.pm = fm + ((wgid % nig) % gsz); u.pn = (wgid % nig) / gsz; u.ks = 0; return true;
    }
    __device__ __forceinline__ void a_ready(const Unit&) const {}
    __device__ __forceinline__ void done(const Unit&) const {}
};

__device__ __forceinline__ unsigned cvt_pk_bf16(float lo, float hi) { unsigned r; asm volatile("v_cvt_pk_bf16_f32 %0, %1, %2" : "=v"(r) : "v"(lo), "v"(hi)); return r; }

constexpr float RMS_EPS = 1e-6f;
template <bool SLOTS> __device__ __forceinline__ float row_ss(const float* ss, int row) {
    if (!SLOTS) return ss[row];
    const f32x4* p = (const f32x4*)(ss + (size_t)row * 16); const f32x4 a = p[0], b = p[1], c = p[2], d = p[3];
    return (((a[0] + a[1]) + (a[2] + a[3])) + ((b[0] + b[1]) + (b[2] + b[3]))) + (((c[0] + c[1]) + (c[2] + c[3])) + ((d[0] + d[1]) + (d[2] + d[3])));
}
#ifndef G1_NT
#define G1_NT 0
#endif
#ifndef WT_STORES
#define WT_STORES 0
#endif
__device__ __forceinline__ void st16(void* p, u32x4 v) { if (WT_STORES) asm volatile("global_store_dwordx4 %0, %1, off sc1\n\ts_nop 2" :: "v"(p), "v"(v) : "memory"); else *(u32x4*)p = v; }
__device__ __forceinline__ void st16f(void* p, f32x4 v) { if (WT_STORES) asm volatile("global_store_dwordx4 %0, %1, off sc1\n\ts_nop 2" :: "v"(p), "v"(v) : "memory"); else *(f32x4*)p = v; }
__device__ __forceinline__ void st8(void* p, unsigned long long v) { if (WT_STORES) asm volatile("global_store_dwordx2 %0, %1, off sc1\n\ts_nop 2" :: "v"(p), "v"(v) : "memory"); else *(unsigned long long*)p = v; }
__device__ __forceinline__ float row_rstd(unsigned rsl, int row) { return *(const PG8_LAS float*)(rsl + 4u * (unsigned)(row & 255)); }
#ifndef FP8_SOFT_ENCODE
#define FP8_SOFT_ENCODE 0
#endif
__device__ __forceinline__ unsigned enc_e4m3_soft(float x) {
    const unsigned u = __float_as_uint(x), a = u & 0x7fffffffu, sg = (u >> 24) & 0x80u; unsigned r;
    if (a >= 0x3c800000u) { r = (a + 0x7ffffu + ((a >> 20) & 1u)) >> 20; r -= (127u - 7u) << 3; r = r > 0x7eu ? 0x7eu : r; }
    else { r = (unsigned)__builtin_rintf(__uint_as_float(a) * 512.0f); }
    return r | sg;
}
__device__ __forceinline__ unsigned pk4_fp8(float a, float b, float c, float d) {
    a = __builtin_amdgcn_fmed3f(a, -448.f, 448.f); b = __builtin_amdgcn_fmed3f(b, -448.f, 448.f); c = __builtin_amdgcn_fmed3f(c, -448.f, 448.f); d = __builtin_amdgcn_fmed3f(d, -448.f, 448.f);
    if (FP8_SOFT_ENCODE) return enc_e4m3_soft(a) | (enc_e4m3_soft(b) << 8) | (enc_e4m3_soft(c) << 16) | (enc_e4m3_soft(d) << 24);
    unsigned w = 0u; w = (unsigned)__builtin_amdgcn_cvt_pk_fp8_f32(a, b, (int)w, false); w = (unsigned)__builtin_amdgcn_cvt_pk_fp8_f32(c, d, (int)w, true); return w;
}
template <int MODE, bool ACCI = false> struct EpiScale {
    static constexpr bool PERM = true, AFTER_DRAIN = false;
    bf16_t* O; int ldc; const float* ss; const float* cosT; const float* sinT; float qscale; int skip; float accscale; unsigned rsl; int pml;
    template <bool ROPE> __device__ __forceinline__ void body(const f32x4 (&acc)[2][2][4][2], const Unit& u, int wr, int wc, int fr, int fq, int kind3, float os) const {
        const int row0 = u.pm * BM + wr * 64 + fr, col0 = u.pn * BM + wc * 32 + 8 * fq;
        const int j4 = ((4 * wc + fq) & 7) * 4;
        const int br = (u.pn % 12) >> 2, sh = 2 * br, hbase = 4 * (u.pn & 3) + (wc >> 1), doff = 32 * (wc & 1) + 8 * fq;
#pragma unroll
        for (int ai = 0; ai < 2; ++ai)
#pragma unroll
            for (int m = 0; m < 4; ++m) { const int row = row0 + ai * HALF + m * 16;
                const float s = row_rstd(rsl, row) * accscale * os;
                f32x4 cs = (f32x4){1.f, 1.f, 1.f, 1.f}, sn = (f32x4){0.f, 0.f, 0.f, 0.f};
                if (ROPE) { const int pos = row & 4095; cs = *(const f32x4*)(cosT + pos * 32 + j4); sn = *(const f32x4*)(sinT + pos * 32 + j4); }
                bf16_t* rowp = O + (size_t)row * ldc + col0;
                unsigned char* rowp8 = nullptr;
                if (MODE == 1) { const int t = row & 4095, b = row >> 12; const int pos = ((t & ((1 << sh) - 1)) << (12 - sh)) + (t >> sh);
                    rowp8 = (unsigned char*)O + (size_t)(kind3 * 3 + br) * ((size_t)16384 * 1024) + ((size_t)(b * 16 + hbase) * 4096 + pos) * 64 + doff; }
#pragma unroll
                for (int bj = 0; bj < 2; ++bj) { f32x4 v0 = (ACCI ? __builtin_convertvector(__builtin_bit_cast(v4i_t, acc[ai][bj][m][0]), f32x4) : acc[ai][bj][m][0]) * s, v1 = (ACCI ? __builtin_convertvector(__builtin_bit_cast(v4i_t, acc[ai][bj][m][1]), f32x4) : acc[ai][bj][m][1]) * s;
                    if (ROPE) { const f32x4 r0 = v0 * cs - v1 * sn, r1 = v1 * cs + v0 * sn; v0 = r0; v1 = r1; }
                    if (MODE == 1) {
                        if (!skip) st8(rowp8 + bj * (2 * 4096 * 64), (unsigned long long)pk4_fp8(v0[0], v0[1], v0[2], v0[3]) | ((unsigned long long)pk4_fp8(v1[0], v1[1], v1[2], v1[3]) << 32)); }
                    else { u32x4 w; w.x = cvt_pk_bf16(v0[0], v0[1]); w.y = cvt_pk_bf16(v0[2], v0[3]); w.z = cvt_pk_bf16(v1[0], v1[1]); w.w = cvt_pk_bf16(v1[2], v1[3]);
                        if (!skip) { if (G1_NT) __builtin_nontemporal_store(w, (u32x4*)(rowp + bj * HALF)); else st16(rowp + bj * HALF, w); } } } }
    }
    __device__ __forceinline__ void operator()(const f32x4 (&acc)[2][2][4][2], const Unit& u, int wr, int wc, int fr, int fq) const {
        if (MODE != 1) { body<false>(acc, u, wr, wc, fr, fq, 0, 1.f); return; }
        const int kind3 = u.pn / 12;
        if (kind3 == 1) body<false>(acc, u, wr, wc, fr, fq, kind3, 16.f);
        else body<true>(acc, u, wr, wc, fr, fq, kind3, kind3 == 2 ? qscale * 64.f : 16.f);
    }
};
__device__ __forceinline__ unsigned pk4_i8(float a, float b, float c, float d) {
    const int ia = (int)__builtin_rintf(__builtin_amdgcn_fmed3f(a, -127.f, 127.f)), ib = (int)__builtin_rintf(__builtin_amdgcn_fmed3f(b, -127.f, 127.f));
    const int ic = (int)__builtin_rintf(__builtin_amdgcn_fmed3f(c, -127.f, 127.f)), id = (int)__builtin_rintf(__builtin_amdgcn_fmed3f(d, -127.f, 127.f));
    return ((unsigned)ia & 0xffu) | (((unsigned)ib & 0xffu) << 8) | (((unsigned)ic & 0xffu) << 16) | ((unsigned)id << 24);
}
template <bool SS, bool RB16, bool F32, bool B16, int F8> struct EpiResid {
    static constexpr bool PERM = true, AFTER_DRAIN = false;
    const void* resid; float* hout; bf16_t* hb; unsigned char* h8; float* ssout; float accscale;
    __device__ __forceinline__ void operator()(const f32x4 (&acc)[2][2][4][2], const Unit& u, int wr, int wc, int fr, int fq) const {
        const int row0 = u.pm * BM + wr * 64 + fr, col0 = u.pn * BM + wc * 32 + 8 * fq;
#pragma unroll
        for (int ai = 0; ai < 2; ++ai)
#pragma unroll
            for (int m = 0; m < 4; ++m) { const int row = row0 + ai * HALF + m * 16; float part = 0.f;
#pragma unroll
                for (int bj = 0; bj < 2; ++bj) { const size_t off = (size_t)row * 1024 + col0 + bj * HALF;
                    f32x4 r0, r1;
                    if (RB16) { const u32x4 rr = *(const u32x4*)((const bf16_t*)resid + off);
                        r0 = (f32x4){__uint_as_float(rr.x << 16), __uint_as_float(rr.x & 0xffff0000u), __uint_as_float(rr.y << 16), __uint_as_float(rr.y & 0xffff0000u)};
                        r1 = (f32x4){__uint_as_float(rr.z << 16), __uint_as_float(rr.z & 0xffff0000u), __uint_as_float(rr.w << 16), __uint_as_float(rr.w & 0xffff0000u)}; }
                    else { r0 = *(const f32x4*)((const float*)resid + off); r1 = *(const f32x4*)((const float*)resid + off + 4); }
                    const f32x4 v0 = acc[ai][bj][m][0] * accscale + r0, v1 = acc[ai][bj][m][1] * accscale + r1;
                    if (F32) { st16f(hout + off, v0); st16f(hout + off + 4, v1); }
                    if (F8 == 1) { st8(h8 + off, (unsigned long long)pk4_fp8(v0[0] * 16.f, v0[1] * 16.f, v0[2] * 16.f, v0[3] * 16.f) | ((unsigned long long)pk4_fp8(v1[0] * 16.f, v1[1] * 16.f, v1[2] * 16.f, v1[3] * 16.f) << 32)); }
                    if (F8 == 2) { st8(h8 + off, (unsigned long long)pk4_i8(v0[0] * 21.0f, v0[1] * 21.0f, v0[2] * 21.0f, v0[3] * 21.0f) | ((unsigned long long)pk4_i8(v1[0] * 21.0f, v1[1] * 21.0f, v1[2] * 21.0f, v1[3] * 21.0f) << 32)); }
                    if (B16) { u32x4 w; w.x = cvt_pk_bf16(v0[0], v0[1]); w.y = cvt_pk_bf16(v0[2], v0[3]); w.z = cvt_pk_bf16(v1[0], v1[1]); w.w = cvt_pk_bf16(v1[2], v1[3]);
                        st16(hb + off, w); }
                    if (SS) part += (v0[0] * v0[0] + v0[1] * v0[1]) + (v0[2] * v0[2] + v0[3] * v0[3]) + (v1[0] * v1[0] + v1[1] * v1[1]) + (v1[2] * v1[2] + v1[3] * v1[3]); }
                if (SS) { part += __shfl_xor(part, 16); part += __shfl_xor(part, 32); if (fq == 0) ssout[(size_t)row * 16 + u.pn * 4 + wc] = part; } }
    }
};
template <int SSMODE, bool OUT8, bool ACCI = false> struct EpiSwiglu {
    static constexpr bool PERM = true, AFTER_DRAIN = false;
    void* O; int ldc; const float* ss; int nN; float inscale, outscale; unsigned rsl; int pml; int skip;
    __device__ __forceinline__ void operator()(const f32x4 (&acc)[2][2][4][2], const Unit& u, int wr, int wc, int fr, int fq) const {
        if (skip) return;
        const int pnl = u.pn % nN; const int row0 = u.pm * BM + wr * 64 + fr, col0 = pnl * HALF + wc * 32 + 8 * fq;
#pragma unroll
        for (int ai = 0; ai < 2; ++ai)
#pragma unroll
            for (int m = 0; m < 4; ++m) { const int row = row0 + ai * HALF + m * 16;
                float s = inscale; if (SSMODE != 2) s *= row_rstd(rsl, row);
                f32x4 o[2];
                const float c1 = -1.4426950408889634f * s, c2 = s * s * outscale;
#pragma unroll
                for (int n = 0; n < 2; ++n) { const f32x4 ga = ACCI ? __builtin_convertvector(__builtin_bit_cast(v4i_t, acc[ai][0][m][n]), f32x4) : acc[ai][0][m][n], ua = ACCI ? __builtin_convertvector(__builtin_bit_cast(v4i_t, acc[ai][1][m][n]), f32x4) : acc[ai][1][m][n];
#pragma unroll
                    for (int h2 = 0; h2 < 2; ++h2) { const f32x2 g2 = (f32x2){ga[2 * h2], ga[2 * h2 + 1]}, u2 = (f32x2){ua[2 * h2], ua[2 * h2 + 1]};
                        const f32x2 ex = g2 * c1, gu = g2 * u2; f32x2 e2; e2.x = __builtin_amdgcn_exp2f(ex.x); e2.y = __builtin_amdgcn_exp2f(ex.y);
                        const f32x2 d2 = e2 + 1.0f; f32x2 r2; r2.x = __builtin_amdgcn_rcpf(d2.x); r2.y = __builtin_amdgcn_rcpf(d2.y);
                        const f32x2 o2 = gu * (r2 * c2); o[n][2 * h2] = o2.x; o[n][2 * h2 + 1] = o2.y; } }
                if (OUT8) { st8((unsigned char*)O + (size_t)row * ldc + col0, (unsigned long long)pk4_fp8(o[0][0], o[0][1], o[0][2], o[0][3]) | ((unsigned long long)pk4_fp8(o[1][0], o[1][1], o[1][2], o[1][3]) << 32)); }
                else { u32x4 w; w.x = cvt_pk_bf16(o[0][0], o[0][1]); w.y = cvt_pk_bf16(o[0][2], o[0][3]); w.z = cvt_pk_bf16(o[1][0], o[1][1]); w.w = cvt_pk_bf16(o[1][2], o[1][3]);
                    st16((bf16_t*)O + (size_t)row * ldc + col0, w); } }
    }
};
struct EpiDownMoe {
    static constexpr bool PERM = true, AFTER_DRAIN = false;
    bf16_t* Y; const float* w; float cscale;
    __device__ __forceinline__ void operator()(const f32x4 (&acc)[2][2][4][2], const Unit& u, int wr, int wc, int fr, int fq) const {
        const int pnl = u.pn & 3; const int row0 = u.pm * BM + wr * 64 + fr, col0 = pnl * BM + wc * 32 + 8 * fq;
#pragma unroll
        for (int ai = 0; ai < 2; ++ai)
#pragma unroll
            for (int m = 0; m < 4; ++m) { const int row = row0 + ai * HALF + m * 16; const float s = w[row] * cscale;
                bf16_t* rowp = Y + (size_t)row * 1024 + col0;
#pragma unroll
                for (int bj = 0; bj < 2; ++bj) { const f32x4 v0 = acc[ai][bj][m][0] * s, v1 = acc[ai][bj][m][1] * s;
                    u32x4 w4; w4.x = cvt_pk_bf16(v0[0], v0[1]); w4.y = cvt_pk_bf16(v0[2], v0[3]); w4.z = cvt_pk_bf16(v1[0], v1[1]); w4.w = cvt_pk_bf16(v1[2], v1[3]);
                    st16(rowp + bj * HALF, w4); } }
    }
};
struct PanelOrder {
    int pm, p0, cnt;
    __device__ __forceinline__ bool next(int i, Unit& u) const { if (i >= cnt) return false; int pn = p0 + i; asm volatile("" : "+s"(pn));
        u.pm = pm; u.pn = pn; u.ks = 0; return true; }
    __device__ __forceinline__ void a_ready(const Unit&) const {}
    __device__ __forceinline__ void done(const Unit&) const {}
};
struct LeftOrder {
    int tile0, nleft, G, c, NS; int t1, t2, t3, t4, t5, t6, t7;
    __device__ __forceinline__ bool next(int i, Unit& u) const {
        const int L = i * G + c; if (L >= nleft) return false;
        const int ks = L % NS, rest = L / NS, pnl = rest & 3, pm = tile0 + (rest >> 2);
        const int e = (pm >= t1) + (pm >= t2) + (pm >= t3) + (pm >= t4) + (pm >= t5) + (pm >= t6) + (pm >= t7);
        u.pm = pm; u.pn = e * 4 + pnl; u.ks = ks; return true;
    }
    __device__ __forceinline__ void a_ready(const Unit&) const {}
    __device__ __forceinline__ void done(const Unit&) const {}
};
struct EpiDownPart {
    static constexpr bool PERM = true, AFTER_DRAIN = false;
    bf16_t* P; const float* w; float cscale; int row0, prows;
    __device__ __forceinline__ void operator()(const f32x4 (&acc)[2][2][4][2], const Unit& u, int wr, int wc, int fr, int fq) const {
        const int pnl = u.pn & 3; const int rowb = u.pm * BM + wr * 64 + fr, col0 = pnl * BM + wc * 32 + 8 * fq;
#pragma unroll
        for (int ai = 0; ai < 2; ++ai)
#pragma unroll
            for (int m = 0; m < 4; ++m) { const int row = rowb + ai * HALF + m * 16; const float s = w[row] * cscale;
                bf16_t* rowp = P + ((size_t)u.ks * prows + (row - row0)) * 1024 + col0;
#pragma unroll
                for (int bj = 0; bj < 2; ++bj) { const f32x4 v0 = acc[ai][bj][m][0] * s, v1 = acc[ai][bj][m][1] * s;
                    u32x4 w4; w4.x = cvt_pk_bf16(v0[0], v0[1]); w4.y = cvt_pk_bf16(v0[2], v0[3]); w4.z = cvt_pk_bf16(v1[0], v1[1]); w4.w = cvt_pk_bf16(v1[2], v1[3]);
                    st16(rowp + bj * HALF, w4); } }
    }
};
struct MoeOrder {
    int nM, nN, nwg, G, c; int t1, t2, t3, t4, t5, t6, t7;
    __device__ __forceinline__ bool next(int i, Unit& u) const {
        const long L = (long)i * G + c; if (L >= nwg) return false;
        int wgid = (int)L; { const int q = nwg / NXCD, r = nwg % NXCD, xcd = wgid % NXCD, off = wgid / NXCD; wgid = (xcd < r ? xcd * (q + 1) : r * (q + 1) + (xcd - r) * q) + off; }
        const int nig = WGM * nN, gid = wgid / nig, fm = gid * WGM, gsz = (nM - fm) < WGM ? (nM - fm) : WGM;
        const int pm = fm + ((wgid % nig) % gsz), pnl = (wgid % nig) / gsz;
        const int e = (pm >= t1) + (pm >= t2) + (pm >= t3) + (pm >= t4) + (pm >= t5) + (pm >= t6) + (pm >= t7);
        u.pm = pm; u.pn = e * nN + pnl; u.ks = 0; return true;
    }
    __device__ __forceinline__ void a_ready(const Unit&) const {}
    __device__ __forceinline__ void done(const Unit&) const {}
};
#ifndef FP8_DEBUG_NONSCALED
#define FP8_DEBUG_NONSCALED 0
#endif
template <class Epi, class Sched, bool ALIGN_EPI = false, bool SP2 = false, int FP8 = 0>
__device__ __forceinline__ void gemm_phase(PG8_LAS unsigned char* lds, const Gemm g, const Sched S, const Epi E) {
    const int tid = threadIdx.x, wid = __builtin_amdgcn_readfirstlane(tid >> 6), lane = tid & 63, wr = wid >> 2, wc = wid & 3, fr = lane & 15, fq = lane >> 4;
    const int K = g.K, nt = g.nt ? g.nt : K / BK;
    unsigned voffA[2], voffB[2];
#pragma unroll
    for (int i = 0; i < 2; ++i) { int R, C; stage_rc(tid * 16 + i * 8192, R, C); const int Rb = Epi::PERM ? ((R & ~31) + perm32(R & 31)) : R;
        voffA[i] = (unsigned)(R * K + C) * 2u; voffB[i] = (unsigned)(Rb * K + C) * 2u; }
    const size_t kstep = (size_t)(BK * 2);
    const size_t hstep = (size_t)HALF * K * 2;
    const size_t tstep = 2 * hstep;
    const unsigned ldsw = (unsigned)wid * 1024u;
    const int aoff = lds_byte(wr * 64 + fr, fq * 8), boff = lds_byte(wc * 32 + fr, fq * 8);
#define PG8_SA(b, h) (((b) * 2 + (h)) * HTB)
#define PG8_SB(b, h) ((4 + (b) * 2 + (h)) * HTB)
#define PG8_STAGE(bufoff, gbase, voff) do { _Pragma("unroll") for (int _i = 0; _i < 2; ++_i) \
        __builtin_amdgcn_global_load_lds((const unsigned*)((const char*)(gbase) + (voff)[_i]), (PG8_LAS unsigned*)(lds + (bufoff) + ldsw + _i * 8192), 16, 0, 0); } while (0)
#define PG8_CAT(p0) __builtin_shufflevector(*(const PG8_LAS v4i_t*)(p0), *(const PG8_LAS v4i_t*)((p0) + 1024), 0, 1, 2, 3, 4, 5, 6, 7)
#define PG8_LO(x) __builtin_bit_cast(bf16x8, __builtin_shufflevector((x), (x), 0, 1, 2, 3))
#define PG8_HI(x) __builtin_bit_cast(bf16x8, __builtin_shufflevector((x), (x), 4, 5, 6, 7))
#define PG8_LDA(dst, b, h) do { _Pragma("unroll") for (int m = 0; m < 4; ++m) dst[m] = PG8_CAT(lds + PG8_SA(b, h) + aoff + m * 2048); } while (0)
#define PG8_LDB(dst, b, h) do { _Pragma("unroll") for (int n = 0; n < 2; ++n) dst[n] = PG8_CAT(lds + PG8_SB(b, h) + boff + n * 2048); } while (0)
#define PG8_MMA(ai, bj, At, Bt) do { __builtin_amdgcn_s_setprio(1); \
        if constexpr (FP8 == 2) { _Pragma("unroll") for (int m = 0; m < 4; ++m) _Pragma("unroll") for (int n = 0; n < 2; ++n) { \
            v4i_t c_ = __builtin_bit_cast(v4i_t, acc[ai][bj][m][n]); \
            c_ = __builtin_amdgcn_mfma_i32_16x16x64_i8(__builtin_shufflevector(Bt[n], Bt[n], 0, 1, 2, 3), __builtin_shufflevector(At[m], At[m], 0, 1, 2, 3), c_, 0, 0, 0); \
            c_ = __builtin_amdgcn_mfma_i32_16x16x64_i8(__builtin_shufflevector(Bt[n], Bt[n], 4, 5, 6, 7), __builtin_shufflevector(At[m], At[m], 4, 5, 6, 7), c_, 0, 0, 0); \
            acc[ai][bj][m][n] = __builtin_bit_cast(f32x4, c_); } } \
        else if constexpr (FP8 == 1) { _Pragma("unroll") for (int m = 0; m < 4; ++m) _Pragma("unroll") for (int n = 0; n < 2; ++n) { \
            if (FP8_DEBUG_NONSCALED) { _Pragma("unroll") for (int q = 0; q < 4; ++q) { \
                const long ba = (long)(((unsigned long long)(unsigned)Bt[n][2 * q + 1] << 32) | (unsigned)Bt[n][2 * q]), aa = (long)(((unsigned long long)(unsigned)At[m][2 * q + 1] << 32) | (unsigned)At[m][2 * q]); \
                acc[ai][bj][m][n] = __builtin_amdgcn_mfma_f32_16x16x32_fp8_fp8(ba, aa, acc[ai][bj][m][n], 0, 0, 0); } } \
            else asm volatile("v_mfma_scale_f32_16x16x128_f8f6f4 %0, %1, %2, %0, %3, %3 op_sel_hi:[0,0,0]" : "+v"(acc[ai][bj][m][n]) : "v"(Bt[n]), "v"(At[m]), "v"(sc1)); } } \
        else { _Pragma("unroll") for (int m = 0; m < 4; ++m) _Pragma("unroll") for (int n = 0; n < 2; ++n) { \
            acc[ai][bj][m][n] = __builtin_amdgcn_mfma_f32_16x16x32_bf16(PG8_LO(Bt[n]), PG8_LO(At[m]), acc[ai][bj][m][n], 0, 0, 0); \
            acc[ai][bj][m][n] = __builtin_amdgcn_mfma_f32_16x16x32_bf16(PG8_HI(Bt[n]), PG8_HI(At[m]), acc[ai][bj][m][n], 0, 0, 0); } } \
        __builtin_amdgcn_s_setprio(0); } while (0)
#define PG8_WAIT_V(n) asm volatile("s_waitcnt vmcnt(" #n ")" ::: "memory")
#define PG8_WAIT_L(n) asm volatile("s_waitcnt lgkmcnt(" #n ")" ::: "memory")
#define PG8_BAR __builtin_amdgcn_s_barrier()
#define PG8_SCHED __builtin_amdgcn_sched_barrier(0)
    Unit cur, nxt; int ui = 0;
    if (!S.next(0, cur)) return;
    f32x4 acc[2][2][4][2];
#pragma unroll
    for (int a = 0; a < 2; ++a)
#pragma unroll
        for (int b = 0; b < 2; ++b)
#pragma unroll
            for (int m = 0; m < 4; ++m)
#pragma unroll
                for (int n = 0; n < 2; ++n) acc[a][b][m][n] = (f32x4){0.f, 0.f, 0.f, 0.f};
    v8i_t At[4], B0[2], B1[2];
    const unsigned sc1 = 0x7f7f7f7fu;
    const size_t sstep = (size_t)nt * (BK * 2);
    const char* cA = (const char*)g.A + (size_t)cur.pm * tstep + (size_t)cur.ks * sstep; const char* cB = (const char*)g.Bt + (size_t)cur.pn * tstep + (size_t)cur.ks * sstep;
    S.a_ready(cur);
    if constexpr (SP2) {
        PG8_STAGE(PG8_SB(0, 0), cB, voffB); PG8_STAGE(PG8_SB(0, 1), cB + hstep, voffB); PG8_STAGE(PG8_SA(0, 0), cA, voffA); PG8_STAGE(PG8_SA(0, 1), cA + hstep, voffA);
        if (wr == 1) PG8_BAR;
        PG8_WAIT_V(2); PG8_BAR;
        PG8_STAGE(PG8_SB(1, 0), cB + kstep, voffB); PG8_STAGE(PG8_SA(1, 0), cA + kstep, voffA); PG8_STAGE(PG8_SB(1, 1), cB + hstep + kstep, voffB);
        PG8_WAIT_V(6); PG8_BAR;
    } else {
        PG8_STAGE(PG8_SB(0, 0), cB, voffB); PG8_STAGE(PG8_SA(0, 0), cA, voffA); PG8_STAGE(PG8_SB(0, 1), cB + hstep, voffB); PG8_STAGE(PG8_SA(0, 1), cA + hstep, voffA);
        if (wr == 1) PG8_BAR;
        PG8_WAIT_V(4); PG8_BAR;
        PG8_STAGE(PG8_SB(1, 0), cB + kstep, voffB); PG8_STAGE(PG8_SA(1, 0), cA + kstep, voffA); PG8_STAGE(PG8_SB(1, 1), cB + hstep + kstep, voffB);
        PG8_WAIT_V(6); PG8_BAR;
    }
    for (;;) {
        const bool has_next = S.next(ui + 1, nxt);
        const char* nA = has_next ? (const char*)g.A + (size_t)nxt.pm * tstep + (size_t)nxt.ks * sstep : cA; const char* nB = has_next ? (const char*)g.Bt + (size_t)nxt.pn * tstep + (size_t)nxt.ks * sstep : cB;
#pragma clang loop unroll(disable)
        for (int t = 0; t < nt; t += 2) {
            const bool last = (t == nt - 2);
            const char* a1 = cA + (size_t)(t + 1) * kstep;
            const char* a2 = last ? nA : cA + (size_t)(t + 2) * kstep; const char* b2 = last ? nB : cB + (size_t)(t + 2) * kstep;
            const char* a3 = a2 + kstep; const char* b3 = b2 + kstep;
            if (last && has_next) S.a_ready(nxt);
            if constexpr (SP2) {
            PG8_LDB(B0, 0, 0); PG8_LDB(B1, 0, 1); PG8_SCHED; PG8_LDA(At, 0, 0); PG8_STAGE(PG8_SA(1, 1), a1 + hstep, voffA);
            PG8_WAIT_V(8); PG8_WAIT_L(0); PG8_BAR; PG8_MMA(0, 0, At, B0); PG8_MMA(0, 1, At, B1); PG8_BAR; PG8_SCHED;
            PG8_LDA(At, 0, 1); PG8_STAGE(PG8_SB(0, 0), b2, voffB); PG8_STAGE(PG8_SB(0, 1), b2 + hstep, voffB); PG8_STAGE(PG8_SA(0, 0), a2, voffA);
            PG8_WAIT_V(8); PG8_WAIT_L(0); PG8_BAR; PG8_MMA(1, 0, At, B0); PG8_MMA(1, 1, At, B1); PG8_BAR; PG8_SCHED;
            PG8_LDB(B0, 1, 0); PG8_LDB(B1, 1, 1); PG8_SCHED; PG8_LDA(At, 1, 0); PG8_STAGE(PG8_SA(0, 1), a2 + hstep, voffA);
            PG8_WAIT_V(8); PG8_WAIT_L(0); PG8_BAR; PG8_MMA(0, 0, At, B0); PG8_MMA(0, 1, At, B1); PG8_BAR; PG8_SCHED;
            PG8_LDA(At, 1, 1); PG8_STAGE(PG8_SB(1, 0), b3, voffB); PG8_STAGE(PG8_SB(1, 1), b3 + hstep, voffB); PG8_STAGE(PG8_SA(1, 0), a3, voffA);
            PG8_WAIT_V(8); PG8_WAIT_L(0); PG8_BAR; PG8_MMA(1, 0, At, B0); PG8_MMA(1, 1, At, B1); PG8_BAR; PG8_SCHED;
            } else {
            PG8_LDB(B0, 0, 0); PG8_SCHED; PG8_LDA(At, 0, 0); PG8_STAGE(PG8_SA(1, 1), a1 + hstep, voffA);
            PG8_WAIT_L(8); PG8_BAR; PG8_WAIT_L(0); PG8_MMA(0, 0, At, B0); PG8_BAR; PG8_SCHED;
            PG8_LDB(B1, 0, 1); PG8_STAGE(PG8_SB(0, 0), b2, voffB);
            PG8_BAR; PG8_WAIT_L(0); PG8_MMA(0, 1, At, B1); PG8_BAR;
            PG8_LDA(At, 0, 1); PG8_STAGE(PG8_SA(0, 0), a2, voffA);
            PG8_BAR; PG8_WAIT_L(0); PG8_MMA(1, 0, At, B0); PG8_BAR; PG8_SCHED;
            PG8_STAGE(PG8_SB(0, 1), b2 + hstep, voffB);
            PG8_WAIT_V(6); PG8_BAR; PG8_MMA(1, 1, At, B1); PG8_BAR;
            PG8_LDB(B0, 1, 0); PG8_SCHED; PG8_LDA(At, 1, 0); PG8_STAGE(PG8_SA(0, 1), a2 + hstep, voffA);
            PG8_WAIT_L(8); PG8_BAR; PG8_WAIT_L(0); PG8_MMA(0, 0, At, B0); PG8_BAR; PG8_SCHED;
            PG8_LDB(B1, 1, 1); PG8_STAGE(PG8_SB(1, 0), b3, voffB);
            PG8_BAR; PG8_WAIT_L(0); PG8_MMA(0, 1, At, B1); PG8_BAR;
            PG8_LDA(At, 1, 1); PG8_STAGE(PG8_SA(1, 0), a3, voffA);
            PG8_BAR; PG8_WAIT_L(0); PG8_MMA(1, 0, At, B0); PG8_BAR; PG8_SCHED;
            PG8_STAGE(PG8_SB(1, 1), b3 + hstep, voffB);
            PG8_WAIT_V(6); PG8_BAR; PG8_MMA(1, 1, At, B1); PG8_BAR;
            }
        }
        if constexpr (FP8 == 1) asm volatile("s_nop 15\n\ts_nop 15" ::: "memory");
        if constexpr (ALIGN_EPI) { if (wr == 0) PG8_BAR; }
        if constexpr (!Epi::AFTER_DRAIN) { E(acc, cur, wr, wc, fr, fq); S.done(cur); }
        if (!has_next) break;
#pragma unroll
        for (int a = 0; a < 2; ++a)
#pragma unroll
            for (int b = 0; b < 2; ++b)
#pragma unroll
                for (int m = 0; m < 4; ++m)
#pragma unroll
                    for (int n = 0; n < 2; ++n) acc[a][b][m][n] = (f32x4){0.f, 0.f, 0.f, 0.f};
        cur = nxt; cA = nA; cB = nB; ++ui;
        if constexpr (ALIGN_EPI) { if (wr == 1) PG8_BAR; }
    }
    PG8_WAIT_V(0);
    if constexpr (!ALIGN_EPI) { if (wr == 0) PG8_BAR; }
    PG8_BAR;
    if constexpr (Epi::AFTER_DRAIN) { E.fused(acc, cur, wr, wc, fr, fq, lds, wid, lane); S.done(cur); }
#undef PG8_SA
#undef PG8_SB
#undef PG8_STAGE
#undef PG8_CAT
#undef PG8_LO
#undef PG8_HI
#undef PG8_LDA
#undef PG8_LDB
#undef PG8_MMA
#undef PG8_WAIT_V
#undef PG8_WAIT_L
#undef PG8_BAR
#undef PG8_SCHED
}
}
#define GAS __attribute__((address_space(1)))
#define LAS __attribute__((address_space(3)))
typedef unsigned short bf16;
typedef unsigned v4u __attribute__((ext_vector_type(4)));
typedef float f32x4 __attribute__((ext_vector_type(4)));
typedef short bf16x8 __attribute__((ext_vector_type(8)));
typedef GAS unsigned gu32;
typedef GAS unsigned long long gu64;
#define RLX_AGENT __ATOMIC_RELAXED, __HIP_MEMORY_SCOPE_AGENT
#define LDS_WAIT() asm volatile("s_waitcnt lgkmcnt(0)" ::: "memory")
#define VM_WAIT() asm volatile("s_waitcnt vmcnt(0)" ::: "memory")
__device__ __forceinline__ unsigned long long rt() { return __builtin_amdgcn_s_memrealtime(); }
__device__ __forceinline__ unsigned f2bf(float f) { unsigned u = __builtin_bit_cast(unsigned, f); return (u + 0x7fffu + ((u >> 16) & 1u)) >> 16; }
__device__ __forceinline__ unsigned pk2(float lo, float hi) { return f2bf(lo) | (f2bf(hi) << 16); }

#define XB_TMO      128
#define XB_XCNT(j)  (256  + 64 * (j))
#define XB_XSUB(j)  (1280 + 64 * (j))
#define XB_XGEN(j)  (2304 + 64 * (j))
#define XB_TOP      3328
#define XB_TOPGEN   3392
#define XCD_BAR_WORDS 3456
#define XB_SPIN_CAP (1u << 18)

__device__ __forceinline__ unsigned xb_ld(unsigned* p)              { return __hip_atomic_load(p, __ATOMIC_RELAXED, __HIP_MEMORY_SCOPE_AGENT); }
__device__ __forceinline__ unsigned xb_add(unsigned* p, unsigned v) { return __hip_atomic_fetch_add(p, v, __ATOMIC_RELAXED, __HIP_MEMORY_SCOPE_AGENT); }
__device__ __forceinline__ unsigned xb_xcc_id() { return (unsigned)__builtin_amdgcn_s_getreg((3 << 11) | 20) & 0xFu; }
#define XB_SPIN(cond, bar) do { unsigned _sp = 0; while (cond) { __builtin_amdgcn_s_sleep(1); \
    if ((++_sp & 255u) == 0u) { if (xb_ld(&(bar)[XB_TMO])) break; if (_sp > XB_SPIN_CAP) { atomicAdd(&(bar)[XB_TMO], 1u); break; } } } } while (0)

struct XcdBarrier {
    unsigned* bar; unsigned x;
    volatile LAS unsigned* st;
};

__device__ __forceinline__ XcdBarrier xcd_barrier_post(unsigned* bar, volatile LAS unsigned* st) {
    XcdBarrier b; b.bar = bar; b.x = xb_xcc_id(); b.st = st;
    if (threadIdx.x == 0) (void)xb_add(&bar[XB_XCNT(b.x)], 1u);
    return b;
}
__device__ __forceinline__ void xcd_barrier_complete(unsigned* bar, unsigned x, unsigned& nloc, unsigned& nx) {
    const unsigned G = gridDim.x * gridDim.y * gridDim.z;
    unsigned sum, cnt, mine, sp = 0u;
    for (;;) {
        sum = 0u; cnt = 0u; mine = 0u;
#pragma unroll
        for (unsigned j = 0; j < 16; ++j) { const unsigned c = xb_ld(&bar[XB_XCNT(j)]); sum += c; cnt += (c > 0u) ? 1u : 0u; mine = (j == x) ? c : mine; }
        if (sum == G) break;
        __builtin_amdgcn_s_sleep(1);
        if ((++sp & 255u) == 0u) { if (xb_ld(&bar[XB_TMO])) break; if (sp > XB_SPIN_CAP) { atomicAdd(&bar[XB_TMO], 1u); break; } }
    }
    nloc = mine > 0u ? mine : 1u; nx = cnt > 0u ? cnt : 1u;
}

__device__ __forceinline__ void xcd_barrier(const XcdBarrier& b) {
    asm volatile("s_waitcnt vmcnt(0)" ::: "memory");
    __syncthreads();
    if (threadIdx.x == 0) {
        unsigned* bar = b.bar;
        __builtin_amdgcn_s_waitcnt(0);
        unsigned nloc = b.st[0], nx = b.st[1];
        if (nloc == 0u) { xcd_barrier_complete(bar, b.x, nloc, nx); b.st[0] = nloc; b.st[1] = nx; }
        const unsigned old = xb_add(&bar[XB_XSUB(b.x)], 1u);
        const unsigned gen = old / nloc;
        if (old + 1u == (gen + 1u) * nloc) {
            __builtin_amdgcn_fence(__ATOMIC_RELEASE, "agent");
            asm volatile("s_waitcnt vmcnt(0)" ::: "memory");
            const unsigned og = xb_add(&bar[XB_TOP], 1u);
            const unsigned tg = og / nx;
            if (og + 1u == (tg + 1u) * nx) xb_add(&bar[XB_TOPGEN], 1u);
            else XB_SPIN(xb_ld(&bar[XB_TOPGEN]) == tg, bar);
            __builtin_amdgcn_fence(__ATOMIC_ACQUIRE, "agent");
            xb_add(&bar[XB_XGEN(b.x)], 1u);
            asm volatile("s_waitcnt vmcnt(0)" ::: "memory");
        } else {
            XB_SPIN(xb_ld(&bar[XB_XGEN(b.x)]) == gen, bar);
            __builtin_amdgcn_fence(__ATOMIC_ACQUIRE, "agent");
            asm volatile("s_waitcnt vmcnt(0)" ::: "memory");
        }
    }
    __syncthreads();
}

constexpr int NWAVES = 8, NTHR = 512;
constexpr int T = 16384, D = 1024, SEQ = 4096, NB = 4;
constexpr int FF = 2816, FFE = 3584, NE = 8;
constexpr int NKVQ = 9216;
constexpr float EPS = 1e-6f;
constexpr float QSCALE = 0.125f * 1.4426950408889634f;
constexpr size_t MiB = 1u << 20;
constexpr size_t WS_CTL = 0, CTL_ZERO_BYTES = 64 * 1024;
constexpr size_t WS_TAB = 2 * MiB;
constexpr size_t WS_COS = WS_TAB, WS_SIN = WS_TAB + 512 * 1024, WS_LB = WS_TAB + 1 * MiB, WS_SS0 = WS_LB + 64 * 1024, WS_SS3 = WS_SS0 + 64 * 1024;
constexpr size_t WS_TOKE = WS_TAB + 1 * MiB + 256 * 1024, WS_TOKP = WS_TOKE + 128 * 1024, WS_TOKW = WS_TOKP + 128 * 1024, WS_TOKD = WS_TOKW + 128 * 1024;
constexpr size_t WS_SSS = WS_TOKD + 128 * 1024  , WS_WSORT = WS_TAB + 2 * MiB, WS_DECAY = WS_TAB + 3 * MiB  ;
constexpr size_t WS_SS1 = WS_TAB + 4 * MiB, WS_SS2 = WS_TAB + 5 * MiB;
constexpr size_t WS_QZVG = 8 * MiB;
constexpr size_t WS_KVT = 136 * MiB;
constexpr size_t WS_ST = 200 * MiB;
constexpr size_t WS_OH = 264 * MiB;
constexpr size_t WS_ACTF = 8 * MiB;
constexpr size_t WS_KVQ = 8 * MiB;
constexpr size_t WS_OA = 296 * MiB;
constexpr size_t WS_LSE = 392 * MiB;
constexpr size_t WS_WGU = 8 * MiB;
constexpr size_t WS_WD = 64 * MiB;
constexpr size_t WS_ASORT = 92 * MiB;
constexpr size_t WS_Y = 126 * MiB;
constexpr size_t WS_ACTM = 194 * MiB;
constexpr float I8_SA = 21.0f  , I8_SW = 880.f  ;
constexpr float FP8_SA = 16.f, FP8_SW1 = 64.f, FP8_SACT = 8.f, FP8_SW2 = 128.f;
constexpr size_t WS_WS = 400 * MiB;
constexpr size_t WS_WIN = WS_WS, WS_WOH = WS_WIN + 8 * MiB, WS_WFGU = WS_WOH + 2 * MiB, WS_WFD = WS_WFGU + 11 * MiB, WS_WKVQ = WS_WFD + 6 * MiB, WS_WOD = WS_WKVQ + 18 * MiB;
constexpr size_t WS_HB = 448 * MiB;
constexpr size_t WS_END = 482 * MiB;
static_assert(WS_SS2 + 1 * MiB <= WS_QZVG && WS_WOD + 2 * MiB <= WS_HB && WS_ACTM + (size_t)34816 * 3584 <= WS_WS && WS_LSE + 3 * MiB <= WS_WS, "ws map");
constexpr int MAXROWS = 34816, PART_ROWS = 2048;

constexpr int CW_TMO = 0, CW_CODE = 1, CW_BAR = 1024  , CW_CNT = 8192;
static_assert((CW_BAR + 2 * 3456) <= CW_CNT && (CW_CNT + 8 * 64) * 4 <= (int)CTL_ZERO_BYTES, "every control word lies inside the per-call memset");

constexpr int RING_OFF = 0, RING_BYTES = 131072;
constexpr int LDSCTL_OFF = RING_BYTES, MISC_OFF = LDSCTL_OFF + 320;
constexpr int LDS_BYTES = 147456;

__device__ __forceinline__ float bf2f(unsigned short b) { return __uint_as_float(((unsigned)b) << 16); }
__device__ __forceinline__ float bflo(unsigned w) { return __uint_as_float(w << 16); }
__device__ __forceinline__ float bfhi(unsigned w) { return __uint_as_float(w & 0xffff0000u); }
__device__ __forceinline__ float wave_sum(float v) {
#pragma unroll
    for (int o = 1; o < 64; o <<= 1) v += __shfl_xor(v, o);
    return v;
}
__device__ __forceinline__ float wave_max(float v) {
#pragma unroll
    for (int o = 1; o < 64; o <<= 1) v = fmaxf(v, __shfl_xor(v, o));
    return v;
}

__device__ __forceinline__ void transpose_item(const float* W, int ldw, int K, const float* gain, bf16* WT, int map, int row_off, LAS float* scr, int kb, int nb, int lane) {
    const int k0 = 64 * kb, n0 = 32 * nb;
    float wv[32];
#pragma unroll
    for (int i = 0; i < 32; ++i) { const int kk = 2 * i + (lane >> 5); wv[i] = W[(size_t)(k0 + kk) * ldw + n0 + (lane & 31)]; }
#pragma unroll
    for (int i = 0; i < 32; ++i) { const int kk = 2 * i + (lane >> 5); const float gk = gain ? gain[k0 + kk] : 1.0f; scr[kk * 33 + (lane & 31)] = wv[i] * gk; }
    LDS_WAIT(); asm volatile("" ::: "memory");
    const int c = lane & 7;
#pragma unroll
    for (int j = 0; j < 4; ++j) { const int n = (lane >> 3) + 8 * j; const LAS float* s = scr + (8 * c) * 33 + n;
        v4u o; o.x = pk2(s[0 * 33], s[1 * 33]); o.y = pk2(s[2 * 33], s[3 * 33]); o.z = pk2(s[4 * 33], s[5 * 33]); o.w = pk2(s[6 * 33], s[7 * 33]);
        const int nn = n0 + n; int dr = nn;
        if (map == 1) dr = ((nn >> 7) << 8) + (nn & 127);
        if (map == 2) { const int d = nn & 63; dr = (nn & ~63) + 8 * ((d & 31) >> 2) + 4 * (d >> 5) + (d & 3); }
        *(GAS v4u*)(WT + (size_t)(row_off + dr) * K + k0 + 8 * c) = o; }
    LDS_WAIT(); asm volatile("" ::: "memory");
}


typedef short s16x4 __attribute__((ext_vector_type(4)));
typedef float f32x16 __attribute__((ext_vector_type(16)));
typedef float f32x2_t __attribute__((ext_vector_type(2)));
typedef __bf16 bf16x2_t __attribute__((ext_vector_type(2)));
typedef short v4i16_t __attribute__((ext_vector_type(4)));
#define MFMA32(a, b, c) __builtin_amdgcn_mfma_f32_32x32x16_bf16((a), (b), (c), 0, 0, 0)
__device__ __forceinline__ unsigned cvtpk(float lo, float hi) { f32x2_t v = {lo, hi}; bf16x2_t b = __builtin_convertvector(v, bf16x2_t); return __builtin_bit_cast(unsigned, b); }
__device__ __forceinline__ int crow(int r, int hi) { return (r & 3) + 8 * (r >> 2) + 4 * hi; }
__device__ __forceinline__ s16x4 trd(const LAS char* p) { return __builtin_bit_cast(s16x4, __builtin_amdgcn_ds_read_tr16_b64_v4i16((LAS v4i16_t*)p)); }
__device__ __forceinline__ bf16x8 trpair(const LAS char* p0, const LAS char* p1) { const s16x4 lo = trd(p0), hi = trd(p1); return __builtin_shufflevector(lo, hi, 0, 1, 2, 3, 4, 5, 6, 7); }
#define PACK8(x, s) __builtin_bit_cast(bf16x8, (v4u){cvtpk((x)[8 * (s)], (x)[8 * (s) + 1]), cvtpk((x)[8 * (s) + 2], (x)[8 * (s) + 3]), cvtpk((x)[8 * (s) + 4], (x)[8 * (s) + 5]), cvtpk((x)[8 * (s) + 6], (x)[8 * (s) + 7])})

__device__ __forceinline__ void transpose_item8(const float* W, int ldw, int K, const float* gain, float scale, unsigned char* WT, int map, int row_off, LAS float* scr, int kb, int nb, int lane) {
    const int k0 = 64 * kb, n0 = 32 * nb;
    float wv[32];
#pragma unroll
    for (int i = 0; i < 32; ++i) { const int kk = 2 * i + (lane >> 5); wv[i] = W[(size_t)(k0 + kk) * ldw + n0 + (lane & 31)]; }
#pragma unroll
    for (int i = 0; i < 32; ++i) { const int kk = 2 * i + (lane >> 5); const float gk = gain ? gain[k0 + kk] * scale : scale; scr[kk * 33 + (lane & 31)] = wv[i] * gk; }
    LDS_WAIT(); asm volatile("" ::: "memory");
    const int c = lane & 3;
#pragma unroll
    for (int j = 0; j < 2; ++j) { const int n = (lane >> 2) + 16 * j; const LAS float* s = scr + (16 * c) * 33 + n;
        v4u o; o.x = pg8::pk4_fp8(s[0 * 33], s[1 * 33], s[2 * 33], s[3 * 33]); o.y = pg8::pk4_fp8(s[4 * 33], s[5 * 33], s[6 * 33], s[7 * 33]);
        o.z = pg8::pk4_fp8(s[8 * 33], s[9 * 33], s[10 * 33], s[11 * 33]); o.w = pg8::pk4_fp8(s[12 * 33], s[13 * 33], s[14 * 33], s[15 * 33]);
        const int nn = n0 + n; int dr = nn;
        if (map == 1) dr = ((nn >> 7) << 8) + (nn & 127);
        if (map == 2) { const int d = nn & 63; dr = (nn & ~63) + 8 * ((d & 31) >> 2) + 4 * (d >> 5) + (d & 3); }
        *(GAS v4u*)(WT + (size_t)(row_off + dr) * K + k0 + 16 * c) = o; }
    LDS_WAIT(); asm volatile("" ::: "memory");
}

__device__ __forceinline__ void transpose_item_i8(const float* W, int ldw, int K, const float* gain, float scale, unsigned char* WT, int map, int row_off, LAS float* scr, int kb, int nb, int lane) {
    const int k0 = 64 * kb, n0 = 32 * nb;
    float wv[32];
#pragma unroll
    for (int i = 0; i < 32; ++i) { const int kk = 2 * i + (lane >> 5); wv[i] = W[(size_t)(k0 + kk) * ldw + n0 + (lane & 31)]; }
#pragma unroll
    for (int i = 0; i < 32; ++i) { const int kk = 2 * i + (lane >> 5); const float gk = gain ? gain[k0 + kk] * scale : scale; scr[kk * 33 + (lane & 31)] = wv[i] * gk; }
    LDS_WAIT(); asm volatile("" ::: "memory");
    const int c = lane & 3;
#pragma unroll
    for (int j = 0; j < 2; ++j) { const int n = (lane >> 2) + 16 * j; const LAS float* s = scr + (16 * c) * 33 + n;
        v4u o; o.x = pg8::pk4_i8(s[0 * 33], s[1 * 33], s[2 * 33], s[3 * 33]); o.y = pg8::pk4_i8(s[4 * 33], s[5 * 33], s[6 * 33], s[7 * 33]);
        o.z = pg8::pk4_i8(s[8 * 33], s[9 * 33], s[10 * 33], s[11 * 33]); o.w = pg8::pk4_i8(s[12 * 33], s[13 * 33], s[14 * 33], s[15 * 33]);
        const int nn = n0 + n; int dr = nn;
        if (map == 1) dr = ((nn >> 7) << 8) + (nn & 127);
        *(GAS v4u*)(WT + (size_t)(row_off + dr) * K + k0 + 16 * c) = o; }
    LDS_WAIT(); asm volatile("" ::: "memory");
}

struct Args { const float* in[19]; float* out; unsigned char* ws; int ph_lo, ph_hi, li, pad; };
constexpr int NPHASE = 17;

__global__ void __launch_bounds__(NTHR, 2) fwd_kernel(Args args) {
    extern __shared__ __attribute__((aligned(16))) unsigned char lds_raw[];
    LAS unsigned char* lds = (LAS unsigned char*)lds_raw;
    volatile LAS unsigned* MISC = (volatile LAS unsigned*)(lds + MISC_OFF);
    const int tid = threadIdx.x, lane = tid & 63, wave = __builtin_amdgcn_readfirstlane(tid >> 6);
    const int G = gridDim.x, bid = blockIdx.x;
    const int gw = bid * NWAVES + wave, NGW = G * NWAVES;
#define ctl ((gu32*)(args.ws + WS_CTL))
    const int lo = args.ph_lo, hi = args.ph_hi;
    for (int u = tid; u < (LDS_BYTES - LDSCTL_OFF) / 4; u += NTHR) ((LAS unsigned*)(lds + LDSCTL_OFF))[u] = 0u;
    __syncthreads();
    XcdBarrier bar; bar.bar = (unsigned*)(ctl + CW_BAR) + args.li * XCD_BAR_WORDS; bar.x = 0; bar.st = nullptr;
    if (hi - lo > 1) bar = xcd_barrier_post((unsigned*)(ctl + CW_BAR) + args.li * XCD_BAR_WORDS, MISC + 8);
#define IN(k) (lo <= (k) && (k) < hi)
#if defined(PROBE_NOSTORE)
#define PROBE_SKIP(k) ((args.li == 1 && lo == (k)) ? 1 : 0)
#else
#define PROBE_SKIP(k) 0
#endif
#define SEAM(k) do { if (IN(k) && IN((k) + 1)) xcd_barrier(bar); } while (0)
#define RSTD_TABLE(S_, ssptr_, slots_) LAS float* rsl_ = (LAS float*)(lds + LDSCTL_OFF + 2048); const unsigned rsl = (unsigned)(size_t)rsl_; int pml = -1; { pg8::Unit u0_; if (S_.next(0, u0_)) pml = u0_.pm; \
        if (pml >= 0 && tid < 256) { const int row_ = pml * 256 + tid; const float ssv_ = (slots_) ? pg8::row_ss<true>(ssptr_, row_) : pg8::row_ss<false>(ssptr_, row_); rsl_[tid] = __builtin_amdgcn_rsqf(ssv_ * (1.0f / 1024.0f) + EPS); } \
        __syncthreads(); }
#ifndef F8_SP2
#define F8_SP2 true
#endif
#ifndef MOE_ALIGN
#define MOE_ALIGN true
#endif
#ifndef STAGGER_TICKS
#define STAGGER_TICKS 0
#endif
#ifndef STAGGER1_TICKS
#define STAGGER1_TICKS 0
#endif
#define STAGGER1() do { if (STAGGER1_TICKS) { const unsigned long long t0_ = __builtin_amdgcn_s_memrealtime(); const unsigned long long d_ = (unsigned long long)(((bid >> 3) & 3) * STAGGER1_TICKS); while (__builtin_amdgcn_s_memrealtime() - t0_ < d_) __builtin_amdgcn_s_sleep(8); } } while (0)
#define STAGGER() do { if (STAGGER_TICKS) { const unsigned long long t0_ = __builtin_amdgcn_s_memrealtime(); const unsigned long long d_ = (unsigned long long)(((bid >> 3) & 3) * STAGGER_TICKS); while (__builtin_amdgcn_s_memrealtime() - t0_ < d_) __builtin_amdgcn_s_sleep(8); } } while (0)

#define xin ((const float*)(args.in[0]))
#define attn_norm ((const float*)(args.in[1]))
#define ffn_norm ((const float*)(args.in[2]))
#define hgrn_w_in ((const float*)(args.in[3]))
#define hgrn_lb ((const float*)(args.in[4]))
#define hgrn_onorm ((const float*)(args.in[5]))
#define hgrn_w_out ((const float*)(args.in[6]))
#define kv_norm ((const float*)(args.in[7]))
#define w_kv ((const float*)(args.in[8]))
#define dil_w_q ((const float*)(args.in[9]))
#define dil_w_out ((const float*)(args.in[10]))
#define ffn_wg ((const float*)(args.in[11]))
#define ffn_wu ((const float*)(args.in[12]))
#define ffn_wd ((const float*)(args.in[13]))
#define moe_wr ((const float*)(args.in[14]))
#define moe_wg ((const float*)(args.in[15]))
#define moe_wu ((const float*)(args.in[16]))
#define moe_wd ((const float*)(args.in[17]))
#define final_norm ((const float*)(args.in[18]))
#define hf ((float*)(args.out))
#define hb ((bf16*)((bf16*)(args.ws + WS_HB)))
#define hb8 ((unsigned char*)(args.ws + WS_WIN))
#define hbi8 ((unsigned char*)(args.ws + WS_KVT))
#define W_in8 ((unsigned char*)(args.ws + WS_WIN))
#define xq8 ((unsigned char*)(args.ws + WS_KVT))
#define ypart ((bf16*)(args.ws + WS_ASORT))
#define W_od8 ((unsigned char*)(args.ws + WS_WOD))
#define oa8 ((unsigned char*)(args.ws + WS_LSE + 3 * MiB))
#define W_kvq8 ((unsigned char*)(args.ws + WS_WKVQ))
#define W_fgu8 ((unsigned char*)(args.ws + WS_WFGU))
#define W_fd8 ((unsigned char*)(args.ws + WS_WFD))
#define actf8 ((unsigned char*)(args.ws + WS_ACTF))
#define cosT ((float*)((float*)(args.ws + WS_COS)))
#define sinT ((float*)((float*)(args.ws + WS_SIN)))
#define lbv ((float*)((float*)(args.ws + WS_LB)))
#define ss0 ((float*)((float*)(args.ws + WS_SS0)))
#define ss1 ((float*)((float*)(args.ws + WS_SS1)))
#define ss2 ((float*)((float*)(args.ws + WS_SS2)))
#define ss3 ((float*)((float*)(args.ws + WS_SS3)))
#define W_in ((bf16*)((bf16*)(args.ws + WS_WIN)))
#define W_oh ((bf16*)((bf16*)(args.ws + WS_WOH)))
#define W_fgu ((bf16*)((bf16*)(args.ws + WS_WFGU)))
#define W_fd ((bf16*)((bf16*)(args.ws + WS_WFD)))
#define W_kvq ((bf16*)((bf16*)(args.ws + WS_WKVQ)))
#define W_od ((bf16*)((bf16*)(args.ws + WS_WOD)))
#define W_gu ((unsigned char*)(args.ws + WS_WGU))
#define W_d ((unsigned char*)(args.ws + WS_WD))
#define qzvg ((bf16*)((bf16*)(args.ws + WS_QZVG)))
#define kvT ((bf16*)((bf16*)(args.ws + WS_KVT)))
#define stT ((bf16*)((bf16*)(args.ws + WS_ST)))
#define oh ((bf16*)((bf16*)(args.ws + WS_OH)))
#define actf ((bf16*)((bf16*)(args.ws + WS_ACTF)))
#define kvq ((bf16*)((bf16*)(args.ws + WS_KVQ)))
#define kvq8 ((const unsigned char*)(args.ws + WS_KVQ))
#define oa ((bf16*)((bf16*)(args.ws + WS_OA)))
#define asort ((unsigned char*)(args.ws + WS_ASORT))
#define actm ((unsigned char*)(args.ws + WS_ACTM))
#define ymoe ((bf16*)((bf16*)(args.ws + WS_Y)))
#define decay ((float*)((float*)(args.ws + WS_DECAY)))
#define tok_e ((int*)((int*)(args.ws + WS_TOKE)))
#define tok_p ((int*)((int*)(args.ws + WS_TOKP)))
#define tok_w ((float*)((float*)(args.ws + WS_TOKW)))
#define tok_d ((int*)((int*)(args.ws + WS_TOKD)))
#define ss_sorted ((float*)((float*)(args.ws + WS_SSS)))
#define w_sorted ((float*)((float*)(args.ws + WS_WSORT)))
    if (IN(0)) {
        LAS float* scr = (LAS float*)(lds + RING_OFF + wave * 16384);
        constexpr int I_IN = 16 * 128, I_OH = 16 * 32, I_FG = 16 * 88, I_FD = 44 * 32, I_KV = 16 * 96;
        constexpr int NIT = I_IN + I_OH + 2 * I_FG + I_FD + 3 * I_KV + I_OH;
        for (int it = gw; it < NIT; it += NGW) {
            int r = it;
            if (r < I_IN) { transpose_item(hgrn_w_in, 4096, 1024, attn_norm, W_in, 0, 0, scr, r / 128, r % 128, lane); continue; } r -= I_IN;
            if (r < I_OH) { transpose_item(hgrn_w_out, 1024, 1024, nullptr, W_oh, 0, 0, scr, r / 32, r % 32, lane); continue; } r -= I_OH;
            if (r < I_FG) { transpose_item_i8(ffn_wg, FF, 1024, ffn_norm, I8_SW, W_fgu8, 1, 0, scr, r / 88, r % 88, lane); continue; } r -= I_FG;
            if (r < I_FG) { transpose_item_i8(ffn_wu, FF, 1024, ffn_norm, I8_SW, W_fgu8, 1, 128, scr, r / 88, r % 88, lane); continue; } r -= I_FG;
            if (r < I_FD) { transpose_item(ffn_wd, 1024, FF, nullptr, W_fd, 0, 0, scr, r / 32, r % 32, lane); continue; } r -= I_FD;
            if (r < I_KV) { transpose_item8(w_kv, 6144, 1024, kv_norm, FP8_SW1, W_kvq8, 2, 0, scr, r / 96, r % 96, lane); continue; } r -= I_KV;
            if (r < I_KV) { transpose_item8(w_kv + 3072, 6144, 1024, kv_norm, FP8_SW1, W_kvq8, 0, 3072, scr, r / 96, r % 96, lane); continue; } r -= I_KV;
            if (r < I_KV) { transpose_item8(dil_w_q, 3072, 1024, attn_norm + 1024, FP8_SW1, W_kvq8, 2, 6144, scr, r / 96, r % 96, lane); continue; } r -= I_KV;
            transpose_item8(dil_w_out, 1024, 1024, nullptr, FP8_SW1, W_od8, 0, 0, scr, r / 32, r % 32, lane);
        }
        for (int m = gw; m < T; m += NGW) {
            const GAS f32x4* xr = (const GAS f32x4*)(xin + (size_t)m * D) + lane; f32x4 v[4]; float s = 0.f;
#pragma unroll
            for (int j = 0; j < 4; ++j) { v[j] = xr[64 * j]; s += (v[j].x * v[j].x + v[j].y * v[j].y) + (v[j].z * v[j].z + v[j].w * v[j].w); }
            s = wave_sum(s);
            GAS unsigned long long* o8 = (GAS unsigned long long*)(hb + (size_t)m * D) + lane;
#pragma unroll
            for (int j = 0; j < 4; ++j) o8[64 * j] = (unsigned long long)pk2(v[j].x, v[j].y) | ((unsigned long long)pk2(v[j].z, v[j].w) << 32);
            if (lane == 0) ss0[m] = s;
        }
        for (int i = bid * NTHR + tid; i < SEQ * 32; i += G * NTHR) {
            const int pos = i >> 5, j = i & 31;
            const float inv = (float)exp2(-(double)j * (13.287712379549449 / 32.0));
            const float ang = (float)pos * inv;
            const double rev = (double)ang * 0.15915494309189535; const float fr = (float)(rev - floor(rev));
            cosT[i] = __builtin_amdgcn_cosf(fr); sinT[i] = __builtin_amdgcn_sinf(fr);
        }
        for (int i = bid * NTHR + tid; i < 1024; i += G * NTHR) lbv[i] = 1.0f / (1.0f + __expf(hgrn_lb[1024 + i] - hgrn_lb[i]));
    }
    SEAM(0);
#if defined(PROBE_BARRIERS)
    if (hi - lo > 1) for (int rr = 0; rr < PROBE_BARRIERS; ++rr) xcd_barrier(bar);
#endif

    if (IN(1)) {
        pg8::Gemm g{hb, W_in, T, 4096, 1024, 0}; pg8::StaticOrder S; S.init(T, 4096, G, bid);
        RSTD_TABLE(S, ss0, false)
        pg8::EpiScale<0, false> E{qzvg, 4096, ss0, nullptr, nullptr, 1.f, PROBE_SKIP(1), 1.0f, rsl, pml};
        STAGGER();
        pg8::gemm_phase<pg8::EpiScale<0, false>, pg8::StaticOrder, true, true>(lds + RING_OFF, g, S, E);
    }
    SEAM(1);

    if (IN(2)) {
        constexpr int PB = 272;
        LAS char* kE = (LAS char*)(lds);
        LAS char* vI = (LAS char*)(lds + 17408);
        LAS float* tot = (LAS float*)(lds + 34816);
        const int dp = tid & 63, seg = tid >> 6, r32 = lane & 31, hh = lane >> 5;
        const int troff = ((lane & 15) >> 2) * PB + (16 * ((lane >> 4) & 1) + 4 * (lane & 3)) * 2;
        const int d0 = 2 * dp;
        unsigned zreg[8], vreg[8];
#define HG2_LOAD(unit_) do { const int b_ = (unit_) >> 9, h_ = ((unit_) >> 6) & 7, c_ = (unit_) & 63; const bf16* rp_ = qzvg + ((size_t)b_ * SEQ + c_ * 64 + 8 * seg) * 4096 + h_ * 128 + d0; \
            _Pragma("unroll") for (int i = 0; i < 8; ++i) { zreg[i] = *(const unsigned*)(rp_ + (size_t)i * 4096 + 1024); vreg[i] = *(const unsigned*)(rp_ + (size_t)i * 4096 + 2048); } } while (0)
        if (bid < 2048) HG2_LOAD(bid);
        for (int unit = bid; unit < 2048; unit += G) {
            const int h = (unit >> 6) & 7;
            const float lb0 = lbv[h * 128 + d0], lb1 = lbv[h * 128 + d0 + 1];
            float bl0[8], bl1[8], k0[8], k1[8]; float run0 = 1.f, run1 = 1.f;
#pragma unroll
            for (int i = 0; i < 8; ++i) { const int t = 8 * seg + i; const unsigned zz = zreg[i];
                const float e0 = __expf(-bflo(zz)), e1 = __expf(-bfhi(zz)), ri0 = __builtin_amdgcn_rcpf(1.f + e0), ri1 = __builtin_amdgcn_rcpf(1.f + e1);
                const float f0 = (1.f + lb0 * e0) * ri0, f1 = (1.f + lb1 * e1) * ri1;
                run0 *= f0; run1 *= f1; bl0[i] = run0; bl1[i] = run1; k0[i] = (1.f - lb0) * e0 * ri0; k1[i] = (1.f - lb1) * e1 * ri1;
                *(LAS unsigned*)(vI + t * PB + d0 * 2) = vreg[i]; }
            if (unit + G < 2048) HG2_LOAD(unit + G);
            tot[seg * 128 + d0] = run0; tot[seg * 128 + d0 + 1] = run1;
            __syncthreads();
            float pre0 = 1.f, pre1 = 1.f, all0 = 1.f, all1 = 1.f;
#pragma unroll
            for (int s = 0; s < 8; ++s) { const float a = tot[s * 128 + d0], bq = tot[s * 128 + d0 + 1]; all0 *= a; all1 *= bq; if (s < seg) { pre0 *= a; pre1 *= bq; } }
#pragma unroll
            for (int i = 0; i < 8; ++i) { const int t = 8 * seg + i;
                *(LAS unsigned*)(kE + t * PB + d0 * 2) = cvtpk(k0[i] * all0 * __builtin_amdgcn_rcpf(pre0 * bl0[i]), k1[i] * all1 * __builtin_amdgcn_rcpf(pre1 * bl1[i])); }
            if (seg == 0) { decay[unit * 128 + d0] = all0; decay[unit * 128 + d0 + 1] = all1; }
            __syncthreads();
            {
                const int dt = wave & 3, vt0 = 2 * (wave >> 2);
                f32x16 A0, A1;
#pragma unroll
                for (int i = 0; i < 16; ++i) { A0[i] = 0.f; A1[i] = 0.f; }
#pragma unroll
                for (int ks = 0; ks < 4; ++ks) { const int rb = (16 * ks + 8 * hh) * PB + troff;
                    const bf16x8 ka = trpair(kE + rb + 64 * dt, kE + rb + 4 * PB + 64 * dt);
                    const bf16x8 v0 = trpair(vI + rb + 64 * vt0, vI + rb + 4 * PB + 64 * vt0), v1 = trpair(vI + rb + 64 * (vt0 + 1), vI + rb + 4 * PB + 64 * (vt0 + 1));
                    A0 = MFMA32(ka, v0, A0); A1 = MFMA32(ka, v1, A1); }
                bf16* o0 = kvT + ((size_t)unit * 128 + 32 * vt0 + r32) * 128 + 32 * dt + 4 * hh;
#pragma unroll
                for (int g = 0; g < 4; ++g) {
                    *(unsigned long long*)(o0 + 8 * g) = (unsigned long long)cvtpk(A0[4 * g], A0[4 * g + 1]) | ((unsigned long long)cvtpk(A0[4 * g + 2], A0[4 * g + 3]) << 32);
                    *(unsigned long long*)(o0 + 32 * 128 + 8 * g) = (unsigned long long)cvtpk(A1[4 * g], A1[4 * g + 1]) | ((unsigned long long)cvtpk(A1[4 * g + 2], A1[4 * g + 3]) << 32); }
            }
            __syncthreads();
        }
#undef HG2_LOAD
    }
    SEAM(2);

    if (IN(3)) {
        for (int idx = bid * NTHR + tid; idx < 32 * 128 * 32; idx += G * NTHR) {
            const int bh = idx >> 12, v = (idx >> 5) & 127, dg = idx & 31;
            f32x4 st = (f32x4){0.f, 0.f, 0.f, 0.f};
#pragma unroll 8
            for (int c = 0; c < 64; ++c) { const size_t unit = (size_t)bh * 64 + c; const size_t o = (unit * 128 + v) * 128 + 4 * dg;
                *(unsigned long long*)(stT + o) = (unsigned long long)pk2(st[0], st[1]) | ((unsigned long long)pk2(st[2], st[3]) << 32);
                const f32x4 dc = *(const f32x4*)(decay + unit * 128 + 4 * dg); const unsigned long long kv = *(const unsigned long long*)(kvT + o);
                const unsigned klo = (unsigned)kv, khi = (unsigned)(kv >> 32);
                st[0] = dc[0] * st[0] + bflo(klo); st[1] = dc[1] * st[1] + bfhi(klo); st[2] = dc[2] * st[2] + bflo(khi); st[3] = dc[3] * st[3] + bfhi(khi); }
        }
    }
    SEAM(3);

    if (IN(4)) {
        constexpr int PB = 272;
        LAS char* qd = (LAS char*)(lds);
        LAS char* kd = (LAS char*)(lds + 17408);
        LAS char* vI = (LAS char*)(lds + 34816);
        LAS float* tot = (LAS float*)(lds + 52224);
        LAS float* ssx = (LAS float*)(lds + 56320);
        const int dp = tid & 63, seg = tid >> 6, r32 = lane & 31, hh = lane >> 5;
        const int troff = ((lane & 15) >> 2) * PB + (16 * ((lane >> 4) & 1) + 4 * (lane & 3)) * 2;
        const int vt = wave & 3, tt = wave >> 2;
        const int d0 = 2 * dp;
        unsigned qreg[8], zreg[8], vreg[8];
        f32x4 onv[4];
#pragma unroll
        for (int g = 0; g < 4; ++g) onv[g] = *(const f32x4*)(hgrn_onorm + 32 * vt + 4 * hh + 8 * g);
#define HG4_LOAD(unit_) do { const int b_ = (unit_) >> 9, h_ = ((unit_) >> 6) & 7, c_ = (unit_) & 63; const bf16* rp_ = qzvg + ((size_t)b_ * SEQ + c_ * 64 + 8 * seg) * 4096 + h_ * 128 + d0; \
            _Pragma("unroll") for (int i = 0; i < 8; ++i) { qreg[i] = *(const unsigned*)(rp_ + (size_t)i * 4096); zreg[i] = *(const unsigned*)(rp_ + (size_t)i * 4096 + 1024); vreg[i] = *(const unsigned*)(rp_ + (size_t)i * 4096 + 2048); } } while (0)
        if (bid < 2048) HG4_LOAD(bid);
        for (int unit = bid; unit < 2048; unit += G) {
            const int b = unit >> 9, h = (unit >> 6) & 7, c = unit & 63; const size_t r0 = (size_t)b * SEQ + c * 64;
            bf16x8 sa[8]; unsigned long long gg[4];
            { const bf16* sp = stT + ((size_t)unit * 128 + 32 * vt + r32) * 128 + 8 * hh;
#pragma unroll
              for (int ks = 0; ks < 8; ++ks) sa[ks] = *(const bf16x8*)(sp + 16 * ks);
              const bf16* gp = qzvg + (r0 + 32 * tt + r32) * 4096 + 3072 + h * 128 + 32 * vt + 4 * hh;
#pragma unroll
              for (int g = 0; g < 4; ++g) gg[g] = *(const unsigned long long*)(gp + 8 * g); }
            const float lb0 = lbv[h * 128 + d0], lb1 = lbv[h * 128 + d0 + 1];
            float bl0[8], bl1[8], k0[8], k1[8], q0[8], q1[8]; float run0 = 1.f, run1 = 1.f;
#pragma unroll
            for (int i = 0; i < 8; ++i) { const int t = 8 * seg + i; const unsigned qq = qreg[i], zz = zreg[i];
                const float e0 = __expf(-bflo(zz)), e1 = __expf(-bfhi(zz)), ri0 = __builtin_amdgcn_rcpf(1.f + e0), ri1 = __builtin_amdgcn_rcpf(1.f + e1);
                const float f0 = (1.f + lb0 * e0) * ri0, f1 = (1.f + lb1 * e1) * ri1;
                run0 *= f0; run1 *= f1; bl0[i] = run0; bl1[i] = run1; k0[i] = (1.f - lb0) * e0 * ri0; k1[i] = (1.f - lb1) * e1 * ri1; q0[i] = bflo(qq); q1[i] = bfhi(qq);
                *(LAS unsigned*)(vI + t * PB + d0 * 2) = vreg[i]; }
            if (unit + G < 2048) HG4_LOAD(unit + G);
            tot[seg * 128 + d0] = run0; tot[seg * 128 + d0 + 1] = run1;
            __syncthreads();
            float pre0 = 1.f, pre1 = 1.f;
#pragma unroll
            for (int s = 0; s < 8; ++s) { if (s < seg) { pre0 *= tot[s * 128 + d0]; pre1 *= tot[s * 128 + d0 + 1]; } }
#pragma unroll
            for (int i = 0; i < 8; ++i) { const int t = 8 * seg + i;
                const float x0 = pre0 * bl0[i], x1 = pre1 * bl1[i];
                *(LAS unsigned*)(qd + t * PB + d0 * 2) = cvtpk(q0[i] * x0, q1[i] * x1);
                *(LAS unsigned*)(kd + t * PB + d0 * 2) = cvtpk(k0[i] * __builtin_amdgcn_rcpf(x0), k1[i] * __builtin_amdgcn_rcpf(x1)); }
            __syncthreads();
            f32x16 O;
            {
                bf16x8 qf[8];
#pragma unroll
                for (int ks = 0; ks < 8; ++ks) qf[ks] = *(const LAS bf16x8*)(qd + (32 * tt + r32) * PB + (16 * ks + 8 * hh) * 2);
#pragma unroll
                for (int i = 0; i < 16; ++i) O[i] = 0.f;
#pragma unroll
                for (int ks = 0; ks < 8; ++ks) O = MFMA32(sa[ks], qf[ks], O);
#pragma unroll
                for (int st = 0; st < 2; ++st) {
                    if (st <= tt) {
                        f32x16 ST;
#pragma unroll
                        for (int i = 0; i < 16; ++i) ST[i] = 0.f;
#pragma unroll
                        for (int ks = 0; ks < 8; ++ks) { const bf16x8 ka = *(const LAS bf16x8*)(kd + (32 * st + r32) * PB + (16 * ks + 8 * hh) * 2); ST = MFMA32(ka, qf[ks], ST); }
                        if (st == tt) {
#pragma unroll
                            for (int i = 0; i < 16; ++i) ST[i] = (crow(i, hh) <= r32) ? ST[i] : 0.f; }
#pragma unroll
                        for (int s2 = 0; s2 < 2; ++s2) { const bf16x8 pb = PACK8(ST, s2);
                            const LAS char* rb = vI + (32 * st + 16 * s2 + 4 * hh) * PB + 64 * vt + troff;
                            const bf16x8 va = trpair(rb, rb + 8 * PB);
                            O = MFMA32(va, pb, O); }
                    }
                }
                float ssq = 0.f;
#pragma unroll
                for (int i = 0; i < 16; ++i) ssq += O[i] * O[i];
                ssq += __shfl_xor(ssq, 32);
                if (hh == 0) ssx[vt * 64 + 32 * tt + r32] = ssq;
            }
            __syncthreads();
            {
                const int t = 32 * tt + r32;
                const float tsum = (ssx[t] + ssx[64 + t]) + (ssx[128 + t] + ssx[192 + t]);
                const float rn = __builtin_amdgcn_rsqf(tsum * (1.f / 128.f) + EPS);
                bf16* op = oh + (r0 + t) * 1024 + h * 128 + 32 * vt + 4 * hh;
#pragma unroll
                for (int g = 0; g < 4; ++g) { const unsigned long long g8 = gg[g]; const f32x4 on = onv[g];
                    const float g0 = bflo((unsigned)g8), g1 = bfhi((unsigned)g8), g2 = bflo((unsigned)(g8 >> 32)), g3 = bfhi((unsigned)(g8 >> 32));
                    const float y0 = O[4 * g] * rn * on[0] * (g0 * __builtin_amdgcn_rcpf(1.f + __expf(-g0))), y1 = O[4 * g + 1] * rn * on[1] * (g1 * __builtin_amdgcn_rcpf(1.f + __expf(-g1)));
                    const float y2 = O[4 * g + 2] * rn * on[2] * (g2 * __builtin_amdgcn_rcpf(1.f + __expf(-g2))), y3 = O[4 * g + 3] * rn * on[3] * (g3 * __builtin_amdgcn_rcpf(1.f + __expf(-g3)));
                    *(unsigned long long*)(op + 8 * g) = (unsigned long long)cvtpk(y0, y1) | ((unsigned long long)cvtpk(y2, y3) << 32); }
            }
            __syncthreads();
        }
#undef HG4_LOAD
    }
    SEAM(4);

    if (IN(5)) {
        pg8::Gemm g{oh, W_oh, T, 1024, 1024, 0}; pg8::StaticOrder S; S.init(T, 1024, G, bid);
        pg8::EpiResid<true, true, false, true, 2> E{hb, nullptr, PROBE_SKIP(5) ? (bf16*)(args.ws + WS_QZVG) : hb, PROBE_SKIP(5) ? (unsigned char*)(args.ws + WS_QZVG + 64 * MiB) : hbi8, PROBE_SKIP(5) ? (float*)(args.ws + WS_QZVG + 96 * MiB) : ss1, 1.0f};
        STAGGER1();
        pg8::gemm_phase<pg8::EpiResid<true, true, false, true, 2>, pg8::StaticOrder, true, true>(lds + RING_OFF, g, S, E);
    }
    SEAM(5);

    if (IN(6)) {
        pg8::Gemm g{(const bf16*)hbi8, (const bf16*)W_fgu8, T, 2 * FF, 512, 0}; pg8::StaticOrder S; S.init(T, 2 * FF, G, bid);
        RSTD_TABLE(S, ss1, true)
        pg8::EpiSwiglu<1, false, true> E{actf, FF, ss1, 22, 1.0f / (I8_SA * I8_SW), 1.0f, rsl, pml, PROBE_SKIP(6)};
        STAGGER();
        pg8::gemm_phase<pg8::EpiSwiglu<1, false, true>, pg8::StaticOrder, true, true, 2>(lds + RING_OFF, g, S, E);
    }
    SEAM(6);

    if (IN(7)) {
        pg8::Gemm g{actf, W_fd, T, 1024, FF, 0}; pg8::StaticOrder S; S.init(T, 1024, G, bid);
        pg8::EpiResid<true, true, false, true, 1> E{hb, nullptr, PROBE_SKIP(7) ? (bf16*)(args.ws + WS_KVT) : hb, PROBE_SKIP(7) ? (unsigned char*)(args.ws + WS_KVT + 32 * MiB) : hb8, PROBE_SKIP(7) ? (float*)(args.ws + WS_KVT + 48 * MiB) : ss2, 1.0f};
        STAGGER1();
        pg8::gemm_phase<pg8::EpiResid<true, true, false, true, 1>, pg8::StaticOrder, true, true>(lds + RING_OFF, g, S, E);
    }
    SEAM(7);

    if (IN(8)) {
        pg8::Gemm g{(const bf16*)hb8, (const bf16*)W_kvq8, T, NKVQ, 512, 0}; pg8::StaticOrder S; S.init(T, NKVQ, G, bid);
        RSTD_TABLE(S, ss2, true)
        pg8::EpiScale<1, false> E{kvq, NKVQ, ss2, cosT, sinT, QSCALE, PROBE_SKIP(8), 1.0f / (FP8_SA * FP8_SW1), rsl, pml};
        STAGGER();
        pg8::gemm_phase<pg8::EpiScale<1, false>, pg8::StaticOrder, MOE_ALIGN, F8_SP2, 1>(lds + RING_OFF, g, S, E);
    }
    SEAM(8);

    if (IN(9)) {
        LAS char* Kimg = (LAS char*)(lds);
        LAS char* Vimg = (LAS char*)(lds + 49152);
        const int r32 = lane & 31, hh = lane >> 5, q4 = (lane & 15) >> 2, p4 = lane & 3, blk = (lane >> 4) & 1;
        float* lse = (float*)(args.ws + WS_LSE);
        const int gper = (3072 + G - 1) / G; const int gend = (bid + 1) * gper < 3072 ? (bid + 1) * gper : 3072;
        v4u pre[6];
#define ATT_CV(w, lo, hi) do { const f32x2_t a_ = __builtin_amdgcn_cvt_pk_f32_fp8((int)(w), false), b_ = __builtin_amdgcn_cvt_pk_f32_fp8((int)(w), true); lo = cvtpk(a_[0], a_[1]); hi = cvtpk(b_[0], b_[1]); } while (0)
#define ATT_DECODE(grp_) const int task0_ = (grp_) * 8; const int br = task0_ >> 13, rem_ = task0_ & 8191, bh = rem_ >> 7, sub_ = rem_ & 127; \
        const int dil = br == 0 ? 1 : (br == 1 ? 4 : 16), nq = 128 / dil, r = sub_ / nq, qt0 = sub_ - r * nq; const int Lsub = SEQ / dil; \
        const unsigned char* kbase = kvq8 + (size_t)br * T * 1024 + ((size_t)bh * 4096 + (size_t)r * Lsub) * 64; const unsigned char* vbase = kbase + (size_t)3 * T * 1024;
#define ATT_LOAD(grp_) do { ATT_DECODE(grp_) _Pragma("unroll") for (int c = 0; c < 6; ++c) { const int idx = tid + 512 * c; const int row = (c < 3 ? idx : idx - 1536) >> 2, qc = idx & 3; \
            int lk = 32 * qt0 - 128 + row; lk = lk < 0 ? 0 : lk; pre[c] = *(const v4u*)((c < 3 ? kbase : vbase) + (size_t)lk * 64 + 16 * qc); } } while (0)
        if (bid * gper < gend) ATT_LOAD(bid * gper);
        for (int grp = bid * gper; grp < gend; ++grp) {
            __syncthreads();
#pragma unroll
            for (int c = 0; c < 6; ++c) { const int idx = tid + 512 * c; const int row = (c < 3 ? idx : idx - 1536) >> 2, qc = idx & 3;
                v4u lo, hi; ATT_CV(pre[c].x, lo.x, lo.y); ATT_CV(pre[c].y, lo.z, lo.w); ATT_CV(pre[c].z, hi.x, hi.y); ATT_CV(pre[c].w, hi.z, hi.w);
                LAS char* img = (c < 3 ? Kimg : Vimg) + row * 128;
                *(LAS v4u*)(img + (((2 * qc) ^ (row & 7)) << 4)) = lo; *(LAS v4u*)(img + (((2 * qc + 1) ^ (row & 7)) << 4)) = hi; }
            __syncthreads();
            if (grp + 1 < gend) ATT_LOAD(grp + 1);
            ATT_DECODE(grp)
            const int b = bh >> 4, h = bh & 15, qt = qt0 + wave;
            const size_t tok0 = (size_t)b * SEQ + r;
            const size_t tokq = tok0 + (size_t)dil * (32 * qt + r32);
            const unsigned char* qp = kbase + (size_t)6 * T * 1024 + (size_t)(32 * qt + r32) * 64 + 8 * hh;
            bf16x8 qf[4];
#pragma unroll
            for (int s4 = 0; s4 < 4; ++s4) { const unsigned long long q8 = *(const unsigned long long*)(qp + 16 * s4);
                const f32x2_t a0 = __builtin_amdgcn_cvt_pk_f32_fp8((int)(unsigned)q8, false), a1 = __builtin_amdgcn_cvt_pk_f32_fp8((int)(unsigned)q8, true);
                const f32x2_t a2 = __builtin_amdgcn_cvt_pk_f32_fp8((int)(unsigned)(q8 >> 32), false), a3 = __builtin_amdgcn_cvt_pk_f32_fp8((int)(unsigned)(q8 >> 32), true);
                const float qs = 1.0f / 1024.0f;
                qf[s4] = __builtin_bit_cast(bf16x8, (v4u){cvtpk(a0[0] * qs, a0[1] * qs), cvtpk(a1[0] * qs, a1[1] * qs), cvtpk(a2[0] * qs, a2[1] * qs), cvtpk(a3[0] * qs, a3[1] * qs)}); }
            f32x16 S[5];
#pragma unroll
            for (int j = 0; j < 5; ++j) {
                const int row = 32 * (wave + j) + r32; const LAS char* kr = Kimg + row * 128;
#pragma unroll
                for (int i = 0; i < 16; ++i) S[j][i] = 0.f;
#pragma unroll
                for (int s4 = 0; s4 < 4; ++s4) { const bf16x8 kf = *(const LAS bf16x8*)(kr + (((2 * s4 + hh) ^ (row & 7)) << 4)); S[j] = MFMA32(kf, qf[s4], S[j]); }
            }
#pragma unroll
            for (int i = 0; i < 16; ++i) { const int key = crow(i, hh); S[0][i] = (key >= r32) ? S[0][i] : -INFINITY; S[4][i] = (key <= r32) ? S[4][i] : -INFINITY; }
            if (qt < 4) {
#pragma unroll
                for (int j = 0; j < 4; ++j)
#pragma unroll
                    for (int i = 0; i < 16; ++i) S[j][i] = (32 * qt - 128 + 32 * j + crow(i, hh) >= 0) ? S[j][i] : -INFINITY; }
            float mx = -INFINITY;
#pragma unroll
            for (int j = 0; j < 5; ++j)
#pragma unroll
                for (int i = 0; i < 16; ++i) mx = fmaxf(mx, S[j][i]);
            mx = fmaxf(mx, __shfl_xor(mx, 32));
            float ls = 0.f;
#pragma unroll
            for (int j = 0; j < 5; ++j)
#pragma unroll
                for (int i = 0; i < 16; ++i) { const float pz = __builtin_amdgcn_exp2f(S[j][i] - mx); S[j][i] = pz; ls += pz; }
            ls += __shfl_xor(ls, 32);
            f32x16 O0, O1;
#pragma unroll
            for (int i = 0; i < 16; ++i) { O0[i] = 0.f; O1[i] = 0.f; }
#pragma unroll
            for (int j = 0; j < 5; ++j) {
#pragma unroll
                for (int s2 = 0; s2 < 2; ++s2) { const bf16x8 pb = PACK8(S[j], s2);
                    const int R = 32 * (wave + j) + 16 * s2 + 4 * hh + q4;
                    const LAS char* rb = Vimg + R * 128 + 8 * (p4 & 1); const int sw = R & 7, c0 = 2 * blk + (p4 >> 1);
                    const bf16x8 va0 = trpair(rb + ((c0 ^ sw) << 4), rb + 8 * 128 + ((c0 ^ sw) << 4)), va1 = trpair(rb + (((4 + c0) ^ sw) << 4), rb + 8 * 128 + (((4 + c0) ^ sw) << 4));
                    O0 = MFMA32(va0, pb, O0); O1 = MFMA32(va1, pb, O1); }
            }
            const float inv = 1.0f / (16.0f * ls);
            bf16* op = oa + (size_t)br * T * 1024 + tokq * 1024 + h * 64 + 4 * hh;
#pragma unroll
            for (int g = 0; g < 4; ++g) {
                *(unsigned long long*)(op + 8 * g) = (unsigned long long)cvtpk(O0[4 * g] * inv, O0[4 * g + 1] * inv) | ((unsigned long long)cvtpk(O0[4 * g + 2] * inv, O0[4 * g + 3] * inv) << 32);
                *(unsigned long long*)(op + 32 + 8 * g) = (unsigned long long)cvtpk(O1[4 * g] * inv, O1[4 * g + 1] * inv) | ((unsigned long long)cvtpk(O1[4 * g + 2] * inv, O1[4 * g + 3] * inv) << 32); }
            if (hh == 0) lse[(size_t)br * T * 16 + tokq * 16 + h] = mx + __log2f(ls);
        }
#undef ATT_DECODE
#undef ATT_LOAD
#undef ATT_CV
    }
    SEAM(9);

    if (IN(10)) {
        const float* lse = (const float*)(args.ws + WS_LSE);
        for (int t = gw; t < T; t += NGW) {
            const int head = lane >> 2;
            const float l0 = lse[(size_t)t * 16 + head], l1 = lse[(size_t)T * 16 + (size_t)t * 16 + head], l2 = lse[(size_t)2 * T * 16 + (size_t)t * 16 + head];
            const float mm = fmaxf(l0, fmaxf(l1, l2));
            float w0 = __builtin_amdgcn_exp2f(l0 - mm), w1 = __builtin_amdgcn_exp2f(l1 - mm), w2 = __builtin_amdgcn_exp2f(l2 - mm);
            const float inv = 1.0f / (w0 + w1 + w2); w0 *= inv; w1 *= inv; w2 *= inv;
            bf16* p0 = oa + (size_t)t * 1024 + 16 * lane;
#pragma unroll
            for (int hf2 = 0; hf2 < 2; ++hf2) {
                const v4u a = *(const v4u*)(p0 + 8 * hf2), bq = *(const v4u*)(p0 + (size_t)T * 1024 + 8 * hf2), cq = *(const v4u*)(p0 + (size_t)2 * T * 1024 + 8 * hf2);
                const float s64 = 64.0f;
                const unsigned lo = pg8::pk4_fp8((w0 * bflo(a.x) + w1 * bflo(bq.x) + w2 * bflo(cq.x)) * s64, (w0 * bfhi(a.x) + w1 * bfhi(bq.x) + w2 * bfhi(cq.x)) * s64,
                                                 (w0 * bflo(a.y) + w1 * bflo(bq.y) + w2 * bflo(cq.y)) * s64, (w0 * bfhi(a.y) + w1 * bfhi(bq.y) + w2 * bfhi(cq.y)) * s64);
                const unsigned hi = pg8::pk4_fp8((w0 * bflo(a.z) + w1 * bflo(bq.z) + w2 * bflo(cq.z)) * s64, (w0 * bfhi(a.z) + w1 * bfhi(bq.z) + w2 * bfhi(cq.z)) * s64,
                                                 (w0 * bflo(a.w) + w1 * bflo(bq.w) + w2 * bflo(cq.w)) * s64, (w0 * bfhi(a.w) + w1 * bfhi(bq.w) + w2 * bfhi(cq.w)) * s64);
                *(unsigned long long*)(oa8 + (size_t)t * 1024 + 16 * lane + 8 * hf2) = (unsigned long long)lo | ((unsigned long long)hi << 32); }
        }
    }
    SEAM(10);

    if (IN(11)) {
        pg8::Gemm g{(const bf16*)oa8, (const bf16*)W_od8, T, 1024, 512, 0}; pg8::StaticOrder S; S.init(T, 1024, G, bid);
        pg8::EpiResid<false, true, false, true, 0> E{hb, nullptr, PROBE_SKIP(11) ? (bf16*)(args.ws + WS_KVQ) : hb, nullptr, nullptr, 1.0f / (64.0f * FP8_SW1)};
        STAGGER1();
        pg8::gemm_phase<pg8::EpiResid<false, true, false, true, 0>, pg8::StaticOrder, true, true, 1>(lds + RING_OFF, g, S, E);
    }
    SEAM(11);

    if (IN(12)) {
        const float* gain = ffn_norm + 1024;
#if defined(PROBE_K)
        if (!(args.li == 1 && lo == 12))
#endif
        for (int t = gw; t < T; t += NGW) {
            const v4u ha = *((const v4u*)(hb + (size_t)t * D) + 2 * lane), hc = *((const v4u*)(hb + (size_t)t * D) + 2 * lane + 1);
            float hv[16];
            hv[0] = bflo(ha.x); hv[1] = bfhi(ha.x); hv[2] = bflo(ha.y); hv[3] = bfhi(ha.y); hv[4] = bflo(ha.z); hv[5] = bfhi(ha.z); hv[6] = bflo(ha.w); hv[7] = bfhi(ha.w);
            hv[8] = bflo(hc.x); hv[9] = bfhi(hc.x); hv[10] = bflo(hc.y); hv[11] = bfhi(hc.y); hv[12] = bflo(hc.z); hv[13] = bfhi(hc.z); hv[14] = bflo(hc.w); hv[15] = bfhi(hc.w);
            float s = 0.f;
#pragma unroll
            for (int i = 0; i < 16; ++i) s += hv[i] * hv[i];
            s = wave_sum(s);
            const float rstd = __builtin_amdgcn_rsqf(s * (1.f / 1024.f) + EPS);
            float lg[8];
#pragma unroll
            for (int e = 0; e < 8; ++e) lg[e] = 0.f;
#pragma unroll
            for (int i = 0; i < 16; ++i) { const int k = 16 * lane + i; const float xv = hv[i] * gain[k];
                const f32x4 w0 = *(const f32x4*)(moe_wr + k * 8), w1 = *(const f32x4*)(moe_wr + k * 8 + 4);
                lg[0] += xv * w0[0]; lg[1] += xv * w0[1]; lg[2] += xv * w0[2]; lg[3] += xv * w0[3]; lg[4] += xv * w1[0]; lg[5] += xv * w1[1]; lg[6] += xv * w1[2]; lg[7] += xv * w1[3]; }
#pragma unroll
            for (int e = 0; e < 8; ++e) lg[e] = wave_sum(lg[e]) * rstd;
            int e1 = 0; float m1 = lg[0];
#pragma unroll
            for (int e = 1; e < 8; ++e) if (lg[e] > m1) { m1 = lg[e]; e1 = e; }
            int e2 = -1; float m2 = -INFINITY;
#pragma unroll
            for (int e = 0; e < 8; ++e) if (e != e1 && lg[e] > m2) { m2 = lg[e]; e2 = e; }
            const float p2 = __expf(m2 - m1); const float w1v = 1.f / (1.f + p2), w2v = p2 / (1.f + p2);
            if (lane == 0) { const unsigned pa = atomicAdd((unsigned*)(ctl + CW_CNT + 64 * e1), 1u), pb = atomicAdd((unsigned*)(ctl + CW_CNT + 64 * e2), 1u);
                tok_e[2 * t] = e1; tok_e[2 * t + 1] = e2; tok_p[2 * t] = (int)pa; tok_p[2 * t + 1] = (int)pb; tok_w[2 * t] = w1v; tok_w[2 * t + 1] = w2v; ss3[t] = s; }
        }
        LAS float* scr = (LAS float*)(lds + RING_OFF + wave * 16384);
        constexpr int I_G = 16 * 112, I_D = 56 * 32, I_E = 2 * I_G + I_D;
        for (int it = gw; it < NE * I_E; it += NGW) {
            const int e = it / I_E; int r = it - e * I_E;
            if (r < I_G) { transpose_item8(moe_wg + (size_t)e * 1024 * FFE, FFE, 1024, gain, FP8_SW1, W_gu + (size_t)e * 7168 * 1024, 1, 0, scr, r / 112, r % 112, lane); continue; } r -= I_G;
            if (r < I_G) { transpose_item8(moe_wu + (size_t)e * 1024 * FFE, FFE, 1024, gain, FP8_SW1, W_gu + (size_t)e * 7168 * 1024, 1, 128, scr, r / 112, r % 112, lane); continue; } r -= I_G;
            transpose_item8(moe_wd + (size_t)e * FFE * 1024, 1024, FFE, nullptr, FP8_SW2, W_d + (size_t)e * 1024 * FFE, 0, 0, scr, r / 32, r % 32, lane);
        }
    }
    SEAM(12);

    int tp1 = 0, tp2 = 0, tp3 = 0, tp4 = 0, tp5 = 0, tp6 = 0, tp7 = 0, tp8 = 0;
    if (hi > 13 && lo <= 15) {
        int c[8];
#pragma unroll
        for (int e = 0; e < 8; ++e) c[e] = (int)((__hip_atomic_load(ctl + CW_CNT + 64 * e, RLX_AGENT) + 255u) >> 8);
        tp1 = c[0]; tp2 = tp1 + c[1]; tp3 = tp2 + c[2]; tp4 = tp3 + c[3]; tp5 = tp4 + c[4]; tp6 = tp5 + c[5]; tp7 = tp6 + c[6]; tp8 = tp7 + c[7];
    }

    if (IN(13)) {
        for (int t = gw; t < T; t += NGW) {
#pragma unroll
            for (int k = 0; k < 2; ++k) { const int e = tok_e[2 * t + k];
                const int tb = e == 0 ? 0 : e == 1 ? tp1 : e == 2 ? tp2 : e == 3 ? tp3 : e == 4 ? tp4 : e == 5 ? tp5 : e == 6 ? tp6 : tp7;
                const int dst = tb * 256 + tok_p[2 * t + k];
                const float rs = __builtin_amdgcn_rsqf(ss3[t] * (1.f / 1024.f) + EPS) * FP8_SA;
                const v4u a = *((const v4u*)(hb + (size_t)t * D) + 2 * lane), bq = *((const v4u*)(hb + (size_t)t * D) + 2 * lane + 1);
                v4u o; o.x = pg8::pk4_fp8(bflo(a.x) * rs, bfhi(a.x) * rs, bflo(a.y) * rs, bfhi(a.y) * rs); o.y = pg8::pk4_fp8(bflo(a.z) * rs, bfhi(a.z) * rs, bflo(a.w) * rs, bfhi(a.w) * rs);
                o.z = pg8::pk4_fp8(bflo(bq.x) * rs, bfhi(bq.x) * rs, bflo(bq.y) * rs, bfhi(bq.y) * rs); o.w = pg8::pk4_fp8(bflo(bq.z) * rs, bfhi(bq.z) * rs, bflo(bq.w) * rs, bfhi(bq.w) * rs);
                *((v4u*)(asort + (size_t)dst * D) + lane) = o;
                if (lane == 0) { w_sorted[dst] = tok_w[2 * t + k]; tok_d[2 * t + k] = dst; } }
        }
    }
    SEAM(13);

    if (IN(14)) {
        pg8::Gemm g{(const bf16*)asort, (const bf16*)W_gu, tp8 * 256, 7168, 512, 0};
        pg8::MoeOrder S{tp8, 28, tp8 * 28, G, bid, tp1, tp2, tp3, tp4, tp5, tp6, tp7};
        pg8::EpiSwiglu<2, true, false> E{actm, FFE, nullptr, 28, 1.0f / (FP8_SA * FP8_SW1), FP8_SACT, 0u, 0, PROBE_SKIP(14)};
        STAGGER();
        pg8::gemm_phase<pg8::EpiSwiglu<2, true, false>, pg8::MoeOrder, MOE_ALIGN, F8_SP2, 1>(lds + RING_OFF, g, S, E);
    }
    SEAM(14);

    if (IN(15)) {
        const int nmain = tp8 < 128 ? tp8 : 128;
        { pg8::Gemm g{(const bf16*)actm, (const bf16*)W_d, nmain * 256, 1024, FFE / 2, 0};
          pg8::MoeOrder S{nmain, 4, nmain * 4, G, bid, tp1, tp2, tp3, tp4, tp5, tp6, tp7};
          pg8::EpiDownMoe E{ymoe, w_sorted, 1.0f / (FP8_SACT * FP8_SW2)};
          pg8::gemm_phase<pg8::EpiDownMoe, pg8::MoeOrder, true, F8_SP2, 1>(lds + RING_OFF, g, S, E); }
        if (tp8 > 128) {
            __syncthreads();
            pg8::Gemm g{(const bf16*)actm, (const bf16*)W_d, tp8 * 256, 1024, FFE / 2, 4};
            pg8::LeftOrder S{128, (tp8 - 128) * 4 * 7, G, bid, 7, tp1, tp2, tp3, tp4, tp5, tp6, tp7};
            pg8::EpiDownPart E{ypart, w_sorted, 1.0f / (FP8_SACT * FP8_SW2), 32768, PART_ROWS};
            pg8::gemm_phase<pg8::EpiDownPart, pg8::LeftOrder, true, true, 1>(lds + RING_OFF, g, S, E);
        }
    }
    SEAM(15);

    if (IN(16)) {
        for (int t = gw; t < T; t += NGW) {
            const int d0 = tok_d[2 * t], d1 = tok_d[2 * t + 1];
            GAS f32x4* hr = (GAS f32x4*)(hf + (size_t)t * D) + lane;
            const GAS unsigned long long* h8p = (const GAS unsigned long long*)(hb + (size_t)t * D) + lane;
            f32x4 v[4]; float s = 0.f;
#pragma unroll
            for (int j = 0; j < 4; ++j) { const unsigned long long hq = h8p[64 * j];
                v[j] = (f32x4){bflo((unsigned)hq), bfhi((unsigned)hq), bflo((unsigned)(hq >> 32)), bfhi((unsigned)(hq >> 32))}; }
#pragma unroll
            for (int k2 = 0; k2 < 2; ++k2) { const int dd = k2 ? d1 : d0;
                if (dd < 32768) { const GAS unsigned long long* yp = (const GAS unsigned long long*)(ymoe + (size_t)dd * D) + lane;
#pragma unroll
                    for (int j = 0; j < 4; ++j) { const unsigned long long a = yp[64 * j]; v[j].x += bflo((unsigned)a); v[j].y += bfhi((unsigned)a); v[j].z += bflo((unsigned)(a >> 32)); v[j].w += bfhi((unsigned)(a >> 32)); } }
                else {
                    f32x4 ys[4];
#pragma unroll
                    for (int j = 0; j < 4; ++j) ys[j] = (f32x4){0.f, 0.f, 0.f, 0.f};
                    for (int ks = 0; ks < 7; ++ks) { const GAS unsigned long long* yp = (const GAS unsigned long long*)(ypart + ((size_t)ks * PART_ROWS + (dd - 32768)) * D) + lane;
#pragma unroll
                        for (int j = 0; j < 4; ++j) { const unsigned long long a = yp[64 * j]; ys[j].x += bflo((unsigned)a); ys[j].y += bfhi((unsigned)a); ys[j].z += bflo((unsigned)(a >> 32)); ys[j].w += bfhi((unsigned)(a >> 32)); } }
#pragma unroll
                    for (int j = 0; j < 4; ++j) v[j] = v[j] + ys[j]; } }
#pragma unroll
            for (int j = 0; j < 4; ++j) s += (v[j].x * v[j].x + v[j].y * v[j].y) + (v[j].z * v[j].z + v[j].w * v[j].w);
            s = wave_sum(s);
            const float rstd = __builtin_amdgcn_rsqf(s * (1.f / 1024.f) + EPS);
#pragma unroll
            for (int j = 0; j < 4; ++j) { const f32x4 gn = *((const GAS f32x4*)final_norm + lane + 64 * j); hr[64 * j] = v[j] * rstd * gn; }
        }
    }
#undef IN
#undef SEAM
#undef xin
#undef attn_norm
#undef ffn_norm
#undef hgrn_w_in
#undef hgrn_lb
#undef hgrn_onorm
#undef hgrn_w_out
#undef kv_norm
#undef w_kv
#undef dil_w_q
#undef dil_w_out
#undef ffn_wg
#undef ffn_wu
#undef ffn_wd
#undef moe_wr
#undef moe_wg
#undef moe_wu
#undef moe_wd
#undef final_norm
#undef hf
#undef hb
#undef hb8
#undef ypart
#undef W_od8
#undef oa8
#undef W_in8
#undef xq8
#undef hbi8
#undef W_kvq8
#undef W_fgu8
#undef W_fd8
#undef actf8
#undef cosT
#undef sinT
#undef lbv
#undef ss0
#undef ss1
#undef ss2
#undef ss3
#undef W_in
#undef W_oh
#undef W_fgu
#undef W_fd
#undef W_kvq
#undef W_od
#undef W_gu
#undef W_d
#undef qzvg
#undef kvT
#undef stT
#undef oh
#undef actf
#undef kvq
#undef kvq8
#undef oa
#undef asort
#undef actm
#undef ymoe
#undef decay
#undef tok_e
#undef tok_p
#undef tok_w
#undef tok_d
#undef ss_sorted
#undef w_sorted
#undef ctl
}

#ifndef MK_N_LAUNCHES
#define MK_N_LAUNCHES 1
#endif
extern "C" void kernel_launch(void* const* d_in, const int* in_sizes, int n_in, void* d_out, int out_size, void* d_ws, size_t ws_size, hipStream_t stream) {
    static int grid = 0;
    if (grid == 0) {
        if (n_in != 19 || in_sizes[0] != T * D || out_size != T * D || ws_size < WS_END) { fprintf(stderr, "kernel_launch: unexpected shapes / workspace (n_in %d, ws %zu); nothing launched\n", n_in, ws_size); grid = -1; return; }
        int dev = 0, cus = 0, per_cu = 0;
        if (hipGetDevice(&dev) != hipSuccess || hipDeviceGetAttribute(&cus, hipDeviceAttributeMultiprocessorCount, dev) != hipSuccess) { grid = -1; return; }
        if (hipFuncSetAttribute((const void*)fwd_kernel, hipFuncAttributeMaxDynamicSharedMemorySize, LDS_BYTES) != hipSuccess) { fprintf(stderr, "kernel_launch: hipFuncSetAttribute failed\n"); grid = -1; return; }
        if (hipOccupancyMaxActiveBlocksPerMultiprocessor(&per_cu, (const void*)fwd_kernel, NTHR, LDS_BYTES) != hipSuccess || per_cu < 1) { fprintf(stderr, "kernel_launch: occupancy query reports %d\n", per_cu); }
        (void)hipGetLastError();
        grid = cus;
        if (grid != 256) { fprintf(stderr, "kernel_launch: built for a 256-CU device (got %d CUs); nothing launched\n", grid); grid = -1; return; }
    }
    if (grid < 0) return;
    if (hipMemsetAsync((char*)d_ws + WS_CTL, 0, CTL_ZERO_BYTES, stream) != hipSuccess) return;
    Args a{};
    for (int i = 0; i < 19; ++i) a.in[i] = (const float*)d_in[i];
    a.out = (float*)d_out; a.ws = (unsigned char*)d_ws;
#if defined(PROBE_K)
    a.ph_lo = 0; a.ph_hi = PROBE_K + 1; a.li = 0; hipLaunchKernelGGL(fwd_kernel, dim3(grid), dim3(NTHR), LDS_BYTES, stream, a);
    a.ph_lo = PROBE_K; a.ph_hi = NPHASE; a.li = 1; hipLaunchKernelGGL(fwd_kernel, dim3(grid), dim3(NTHR), LDS_BYTES, stream, a);
    return;
#endif
    if (MK_N_LAUNCHES == 1) { a.ph_lo = 0; a.ph_hi = NPHASE; hipLaunchKernelGGL(fwd_kernel, dim3(grid), dim3(NTHR), LDS_BYTES, stream, a); }
    else for (int p = 0; p < NPHASE; ++p) { a.ph_lo = p; a.ph_hi = p + 1; hipLaunchKernelGGL(fwd_kernel, dim3(grid), dim3(NTHR), LDS_BYTES, stream, a); }
}
```

```cpp
#include <hip/hip_runtime.h>
#include <cstdio>
#include <cstdint>
#include <cmath>
namespace pg8 {
#define PG8_LAS __attribute__((address_space(3)))
typedef unsigned short bf16_t;
typedef short bf16x8 __attribute__((ext_vector_type(8)));
typedef float f32x4 __attribute__((ext_vector_type(4)));
typedef unsigned u32x4 __attribute__((ext_vector_type(4)));
typedef int v4i_t __attribute__((ext_vector_type(4)));
typedef int v8i_t __attribute__((ext_vector_type(8)));
typedef float f32x2 __attribute__((ext_vector_type(2)));
constexpr int BM = 256, BK = 64, HALF = 128, HTB = HALF * BK * 2  , STAGE_BYTES = 8 * HTB, NXCD = 8, WGM = 8;

__host__ __device__ __forceinline__ int lds_byte(int r, int c) { const int st = (r >> 4) * 2 + (c >> 5), rr = r & 15, cc = c & 31, ob = rr * 64 + cc * 2; return st * 1024 + (ob ^ (((ob >> 9) & 1) << 5)); }
__host__ __device__ __forceinline__ void stage_rc(int b, int& R, int& C) { const int st = b / 1024, sb = b % 1024, swz = sb ^ (((sb >> 9) & 1) << 5); R = (st >> 1) * 16 + swz / 64; C = (st & 1) * 32 + (swz % 64) / 2; }
__host__ __device__ __forceinline__ int perm32(int rho) { const int n = rho >> 4, i = rho & 15; return 8 * (i >> 2) + 4 * n + (i & 3); }

struct Unit { int pm, pn, ks, lo; };
struct Gemm { const bf16_t* A; const bf16_t* Bt; int M, N, K; int nt; const int* rowlist; int rowmax; };

struct StaticOrder {
    int nM, nN, nwg, G, c;
    __host__ __device__ __forceinline__ void init(int M, int N, int G_, int c_) { nM = M / BM; nN = N / BM; nwg = nM * nN; G = G_; c = c_; }
    __host__ __device__ __forceinline__ bool next(int i, Unit& u) const {
        const long L = (long)i * G + c; if (L >= nwg) return false;
        int wgid = (int)L; { const int q = nwg / NXCD, r = nwg % NXCD, xcd = wgid % NXCD, off = wgid / NXCD; wgid = (xcd < r ? xcd * (q + 1) : r * (q + 1) + (xcd - r) * q) + off; }
        const int nig = WGM * nN, gid = wgid / nig, fm = gid * WGM, gsz = (nM - fm) < WGM ? (nM - fm) : WGM;
        u.pm = fm + ((wgid % nig) % gsz); u.pn = (wgid % nig) / gsz; u.ks = 0; u.lo = 0; return true;
    }
    __device__ __forceinline__ void a_ready(const Unit&) const {}
    __device__ __forceinline__ void done(const Unit&) const {}
};

__device__ __forceinline__ unsigned cvt_pk_bf16(float lo, float hi) { unsigned r; asm volatile("v_cvt_pk_bf16_f32 %0, %1, %2" : "=v"(r) : "v"(lo), "v"(hi)); return r; }

constexpr float RMS_EPS = 1e-6f;
template <bool SLOTS> __device__ __forceinline__ float row_ss(const float* ss, int row) {
    if (!SLOTS) return ss[row];
    const f32x4* p = (const f32x4*)(ss + (size_t)row * 16); const f32x4 a = p[0], b = p[1], c = p[2], d = p[3];
    return (((a[0] + a[1]) + (a[2] + a[3])) + ((b[0] + b[1]) + (b[2] + b[3]))) + (((c[0] + c[1]) + (c[2] + c[3])) + ((d[0] + d[1]) + (d[2] + d[3])));
}
#ifndef G1_NT
#define G1_NT 0
#endif
#ifndef WT_STORES
#define WT_STORES 0
#endif
__device__ __forceinline__ void st16(void* p, u32x4 v) { if (WT_STORES) asm volatile("global_store_dwordx4 %0, %1, off sc1\n\ts_nop 2" :: "v"(p), "v"(v) : "memory"); else *(u32x4*)p = v; }
__device__ __forceinline__ void st16f(void* p, f32x4 v) { if (WT_STORES) asm volatile("global_store_dwordx4 %0, %1, off sc1\n\ts_nop 2" :: "v"(p), "v"(v) : "memory"); else *(f32x4*)p = v; }
__device__ __forceinline__ void st8(void* p, unsigned long long v) { if (WT_STORES) asm volatile("global_store_dwordx2 %0, %1, off sc1\n\ts_nop 2" :: "v"(p), "v"(v) : "memory"); else *(unsigned long long*)p = v; }
__device__ __forceinline__ float row_rstd(unsigned rsl, int row) { return *(const PG8_LAS float*)(rsl + 4u * (unsigned)(row & 255)); }
#ifndef FP8_SOFT_ENCODE
#define FP8_SOFT_ENCODE 0
#endif
__device__ __forceinline__ unsigned enc_e4m3_soft(float x) {
    const unsigned u = __float_as_uint(x), a = u & 0x7fffffffu, sg = (u >> 24) & 0x80u; unsigned r;
    if (a >= 0x3c800000u) { r = (a + 0x7ffffu + ((a >> 20) & 1u)) >> 20; r -= (127u - 7u) << 3; r = r > 0x7eu ? 0x7eu : r; }
    else { r = (unsigned)__builtin_rintf(__uint_as_float(a) * 512.0f); }
    return r | sg;
}
__device__ __forceinline__ unsigned pk4_fp8(float a, float b, float c, float d) {
    a = __builtin_amdgcn_fmed3f(a, -448.f, 448.f); b = __builtin_amdgcn_fmed3f(b, -448.f, 448.f); c = __builtin_amdgcn_fmed3f(c, -448.f, 448.f); d = __builtin_amdgcn_fmed3f(d, -448.f, 448.f);
    if (FP8_SOFT_ENCODE) return enc_e4m3_soft(a) | (enc_e4m3_soft(b) << 8) | (enc_e4m3_soft(c) << 16) | (enc_e4m3_soft(d) << 24);
    unsigned w = 0u; w = (unsigned)__builtin_amdgcn_cvt_pk_fp8_f32(a, b, (int)w, false); w = (unsigned)__builtin_amdgcn_cvt_pk_fp8_f32(c, d, (int)w, true); return w;
}
template <int MODE, bool ACCI = false> struct EpiScale {
    static constexpr bool PERM = true, AFTER_DRAIN = false;
    bf16_t* O; int ldc; const float* ss; const float* cosT; const float* sinT; float qscale; int skip; float accscale; unsigned rsl; int pml;
    __device__ __forceinline__ void operator()(const f32x4 (&acc)[2][2][4][2], const Unit& u, int wr, int wc, int fr, int fq) const {
        const int row0 = u.pm * BM + wr * 64 + fr, col0 = u.pn * BM + wc * 32 + 8 * fq;
        const int kind3 = (MODE == 1) ? u.pn / 12 : 0;
        const int kind = (MODE == 1) ? (kind3 == 0 ? 1 : (kind3 == 1 ? 0 : 2)) : 0;
        const int j4 = ((4 * wc + fq) & 7) * 4;
        const int br = (u.pn % 12) >> 2, sh = 2 * br, hbase = 4 * (u.pn & 3) + (wc >> 1), doff = 32 * (wc & 1) + 8 * fq;
#pragma unroll
        for (int ai = 0; ai < 2; ++ai)
#pragma unroll
            for (int m = 0; m < 4; ++m) { const int row = row0 + ai * HALF + m * 16;
                const float s = row_rstd(rsl, row) * accscale;
                f32x4 cs = (f32x4){1.f, 1.f, 1.f, 1.f}, sn = (f32x4){0.f, 0.f, 0.f, 0.f};
                if (MODE == 1 && kind) { const int pos = row & 4095; cs = *(const f32x4*)(cosT + pos * 32 + j4); sn = *(const f32x4*)(sinT + pos * 32 + j4); }
                bf16_t* rowp = O + (size_t)row * ldc + col0;
                unsigned char* rowp8 = nullptr;
                if (MODE == 1) { const int t = row & 4095, b = row >> 12; const int pos = ((t & ((1 << sh) - 1)) << (12 - sh)) + (t >> sh);
                    rowp8 = (unsigned char*)O + (size_t)(kind3 * 3 + br) * ((size_t)16384 * 1024) + ((size_t)(b * 16 + hbase) * 4096 + pos) * 64 + doff; }
                const float os = (MODE == 1) ? (kind == 2 ? qscale * 64.f : 16.f) : 1.f;
#pragma unroll
                for (int bj = 0; bj < 2; ++bj) { f32x4 v0 = (ACCI ? __builtin_convertvector(__builtin_bit_cast(v4i_t, acc[ai][bj][m][0]), f32x4) : acc[ai][bj][m][0]) * s, v1 = (ACCI ? __builtin_convertvector(__builtin_bit_cast(v4i_t, acc[ai][bj][m][1]), f32x4) : acc[ai][bj][m][1]) * s;
                    if (MODE == 1 && kind) { const f32x4 r0 = v0 * cs - v1 * sn, r1 = v1 * cs + v0 * sn; v0 = r0; v1 = r1; }
                    if (MODE == 1) { v0 = v0 * os; v1 = v1 * os;
                        if (!skip) st8(rowp8 + bj * (2 * 4096 * 64), (unsigned long long)pk4_fp8(v0[0], v0[1], v0[2], v0[3]) | ((unsigned long long)pk4_fp8(v1[0], v1[1], v1[2], v1[3]) << 32)); }
                    else { u32x4 w; w.x = cvt_pk_bf16(v0[0], v0[1]); w.y = cvt_pk_bf16(v0[2], v0[3]); w.z = cvt_pk_bf16(v1[0], v1[1]); w.w = cvt_pk_bf16(v1[2], v1[3]);
                        if (!skip) { if (G1_NT) __builtin_nontemporal_store(w, (u32x4*)(rowp + bj * HALF)); else st16(rowp + bj * HALF, w); } } } }
    }
};
__device__ __forceinline__ unsigned pk4_i8(float a, float b, float c, float d) {
    const int ia = (int)__builtin_rintf(__builtin_amdgcn_fmed3f(a, -127.f, 127.f)), ib = (int)__builtin_rintf(__builtin_amdgcn_fmed3f(b, -127.f, 127.f));
    const int ic = (int)__builtin_rintf(__builtin_amdgcn_fmed3f(c, -127.f, 127.f)), id = (int)__builtin_rintf(__builtin_amdgcn_fmed3f(d, -127.f, 127.f));
    return ((unsigned)ia & 0xffu) | (((unsigned)ib & 0xffu) << 8) | (((unsigned)ic & 0xffu) << 16) | ((unsigned)id << 24);
}
template <bool SS, bool RB16, bool F32, bool B16, int F8> struct EpiResid {
    static constexpr bool PERM = true, AFTER_DRAIN = false;
    const void* resid; float* hout; bf16_t* hb; unsigned char* h8; float* ssout; float accscale;
    __device__ __forceinline__ void operator()(const f32x4 (&acc)[2][2][4][2], const Unit& u, int wr, int wc, int fr, int fq) const {
        const int row0 = u.pm * BM + wr * 64 + fr, col0 = u.pn * BM + wc * 32 + 8 * fq;
#pragma unroll
        for (int ai = 0; ai < 2; ++ai)
#pragma unroll
            for (int m = 0; m < 4; ++m) { const int row = row0 + ai * HALF + m * 16; float part = 0.f;
#pragma unroll
                for (int bj = 0; bj < 2; ++bj) { const size_t off = (size_t)row * 1024 + col0 + bj * HALF;
                    f32x4 r0, r1;
                    if (RB16) { const u32x4 rr = *(const u32x4*)((const bf16_t*)resid + off);
                        r0 = (f32x4){__uint_as_float(rr.x << 16), __uint_as_float(rr.x & 0xffff0000u), __uint_as_float(rr.y << 16), __uint_as_float(rr.y & 0xffff0000u)};
                        r1 = (f32x4){__uint_as_float(rr.z << 16), __uint_as_float(rr.z & 0xffff0000u), __uint_as_float(rr.w << 16), __uint_as_float(rr.w & 0xffff0000u)}; }
                    else { r0 = *(const f32x4*)((const float*)resid + off); r1 = *(const f32x4*)((const float*)resid + off + 4); }
                    const f32x4 v0 = acc[ai][bj][m][0] * accscale + r0, v1 = acc[ai][bj][m][1] * accscale + r1;
                    if (F32) { st16f(hout + off, v0); st16f(hout + off + 4, v1); }
                    if (F8 == 1) { st8(h8 + off, (unsigned long long)pk4_fp8(v0[0] * 16.f, v0[1] * 16.f, v0[2] * 16.f, v0[3] * 16.f) | ((unsigned long long)pk4_fp8(v1[0] * 16.f, v1[1] * 16.f, v1[2] * 16.f, v1[3] * 16.f) << 32)); }
                    if (F8 == 2) { st8(h8 + off, (unsigned long long)pk4_i8(v0[0] * 21.0f, v0[1] * 21.0f, v0[2] * 21.0f, v0[3] * 21.0f) | ((unsigned long long)pk4_i8(v1[0] * 21.0f, v1[1] * 21.0f, v1[2] * 21.0f, v1[3] * 21.0f) << 32)); }
                    if (B16) { u32x4 w; w.x = cvt_pk_bf16(v0[0], v0[1]); w.y = cvt_pk_bf16(v0[2], v0[3]); w.z = cvt_pk_bf16(v1[0], v1[1]); w.w = cvt_pk_bf16(v1[2], v1[3]);
                        st16(hb + off, w); }
                    if (SS) part += (v0[0] * v0[0] + v0[1] * v0[1]) + (v0[2] * v0[2] + v0[3] * v0[3]) + (v1[0] * v1[0] + v1[1] * v1[1]) + (v1[2] * v1[2] + v1[3] * v1[3]); }
                if (SS) { part += __shfl_xor(part, 16); part += __shfl_xor(part, 32); if (fq == 0) ssout[(size_t)row * 16 + u.pn * 4 + wc] = part; } }
    }
};
template <int SSMODE, bool OUT8, bool ACCI = false> struct EpiSwiglu {
    static constexpr bool PERM = true, AFTER_DRAIN = false;
    void* O; int ldc; const float* ss; int nN; float inscale, outscale; unsigned rsl; int pml; int skip;
    __device__ __forceinline__ void operator()(const f32x4 (&acc)[2][2][4][2], const Unit& u, int wr, int wc, int fr, int fq) const {
        if (skip) return;
        const int pnl = u.pn % nN; const int row0 = u.pm * BM + wr * 64 + fr, col0 = pnl * HALF + wc * 32 + 8 * fq;
#pragma unroll
        for (int ai = 0; ai < 2; ++ai)
#pragma unroll
            for (int m = 0; m < 4; ++m) { const int row = row0 + ai * HALF + m * 16;
                float s = inscale; if (SSMODE != 2) s *= row_rstd(rsl, row);
                f32x4 o[2];
                const float c1 = -1.4426950408889634f * s, c2 = s * s * outscale;
#pragma unroll
                for (int n = 0; n < 2; ++n) { const f32x4 ga = ACCI ? __builtin_convertvector(__builtin_bit_cast(v4i_t, acc[ai][0][m][n]), f32x4) : acc[ai][0][m][n], ua = ACCI ? __builtin_convertvector(__builtin_bit_cast(v4i_t, acc[ai][1][m][n]), f32x4) : acc[ai][1][m][n];
#pragma unroll
                    for (int h2 = 0; h2 < 2; ++h2) { const f32x2 g2 = (f32x2){ga[2 * h2], ga[2 * h2 + 1]}, u2 = (f32x2){ua[2 * h2], ua[2 * h2 + 1]};
                        const f32x2 ex = g2 * c1, gu = g2 * u2; f32x2 e2; e2.x = __builtin_amdgcn_exp2f(ex.x); e2.y = __builtin_amdgcn_exp2f(ex.y);
                        const f32x2 d2 = e2 + 1.0f; f32x2 r2; r2.x = __builtin_amdgcn_rcpf(d2.x); r2.y = __builtin_amdgcn_rcpf(d2.y);
                        const f32x2 o2 = gu * (r2 * c2); o[n][2 * h2] = o2.x; o[n][2 * h2 + 1] = o2.y; } }
                if (OUT8) { st8((unsigned char*)O + (size_t)row * ldc + col0, (unsigned long long)pk4_fp8(o[0][0], o[0][1], o[0][2], o[0][3]) | ((unsigned long long)pk4_fp8(o[1][0], o[1][1], o[1][2], o[1][3]) << 32)); }
                else { u32x4 w; w.x = cvt_pk_bf16(o[0][0], o[0][1]); w.y = cvt_pk_bf16(o[0][2], o[0][3]); w.z = cvt_pk_bf16(o[1][0], o[1][1]); w.w = cvt_pk_bf16(o[1][2], o[1][3]);
                    st16((bf16_t*)O + (size_t)row * ldc + col0, w); } }
    }
};
struct EpiDownMoe {
    static constexpr bool PERM = true, AFTER_DRAIN = false;
    bf16_t* Y; const float* w; float cscale;
    __device__ __forceinline__ void operator()(const f32x4 (&acc)[2][2][4][2], const Unit& u, int wr, int wc, int fr, int fq) const {
        const int pnl = u.pn & 3; const int row0 = u.pm * BM + wr * 64 + fr, col0 = pnl * BM + wc * 32 + 8 * fq;
#pragma unroll
        for (int ai = 0; ai < 2; ++ai)
#pragma unroll
            for (int m = 0; m < 4; ++m) { const int row = row0 + ai * HALF + m * 16; const float s = w[row] * cscale;
                bf16_t* rowp = Y + (size_t)row * 1024 + col0;
#pragma unroll
                for (int bj = 0; bj < 2; ++bj) { const f32x4 v0 = acc[ai][bj][m][0] * s, v1 = acc[ai][bj][m][1] * s;
                    u32x4 w4; w4.x = cvt_pk_bf16(v0[0], v0[1]); w4.y = cvt_pk_bf16(v0[2], v0[3]); w4.z = cvt_pk_bf16(v1[0], v1[1]); w4.w = cvt_pk_bf16(v1[2], v1[3]);
                    st16(rowp + bj * HALF, w4); } }
    }
};
struct PanelOrder {
    int pm, p0, cnt;
    __device__ __forceinline__ bool next(int i, Unit& u) const { if (i >= cnt) return false; int pn = p0 + i; asm volatile("" : "+s"(pn));
        u.pm = pm; u.pn = pn; u.ks = 0; u.lo = 0; return true; }
    __device__ __forceinline__ void a_ready(const Unit&) const {}
    __device__ __forceinline__ void done(const Unit&) const {}
};
struct LeftOrder {
    int tile0, nleft, G, c, NS; int t1, t2, t3, t4, t5, t6, t7;
    __device__ __forceinline__ bool next(int i, Unit& u) const {
        const int L = i * G + c; if (L >= nleft) return false;
        const int ks = L % NS, rest = L / NS, pnl = rest & 3, pm = tile0 + (rest >> 2);
        const int e = (pm >= t1) + (pm >= t2) + (pm >= t3) + (pm >= t4) + (pm >= t5) + (pm >= t6) + (pm >= t7);
        u.pm = pm; u.pn = e * 4 + pnl; u.ks = ks; u.lo = 0; return true;
    }
    __device__ __forceinline__ void a_ready(const Unit&) const {}
    __device__ __forceinline__ void done(const Unit&) const {}
};
struct EpiDownPart {
    static constexpr bool PERM = true, AFTER_DRAIN = false;
    bf16_t* P; const float* w; float cscale; int row0, prows;
    __device__ __forceinline__ void operator()(const f32x4 (&acc)[2][2][4][2], const Unit& u, int wr, int wc, int fr, int fq) const {
        const int pnl = u.pn & 3; const int rowb = u.pm * BM + wr * 64 + fr, col0 = pnl * BM + wc * 32 + 8 * fq;
#pragma unroll
        for (int ai = 0; ai < 2; ++ai)
#pragma unroll
            for (int m = 0; m < 4; ++m) { const int row = rowb + ai * HALF + m * 16; const float s = w[row] * cscale;
                bf16_t* rowp = P + ((size_t)u.ks * prows + (row - row0)) * 1024 + col0;
#pragma unroll
                for (int bj = 0; bj < 2; ++bj) { const f32x4 v0 = acc[ai][bj][m][0] * s, v1 = acc[ai][bj][m][1] * s;
                    u32x4 w4; w4.x = cvt_pk_bf16(v0[0], v0[1]); w4.y = cvt_pk_bf16(v0[2], v0[3]); w4.z = cvt_pk_bf16(v1[0], v1[1]); w4.w = cvt_pk_bf16(v1[2], v1[3]);
                    st16(rowp + bj * HALF, w4); } }
    }
};
struct MoeOrder {
    int nM, nN, nwg, G, c; int t1, t2, t3, t4, t5, t6, t7;
    __device__ __forceinline__ bool next(int i, Unit& u) const {
        const long L = (long)i * G + c; if (L >= nwg) return false;
        int wgid = (int)L; { const int q = nwg / NXCD, r = nwg % NXCD, xcd = wgid % NXCD, off = wgid / NXCD; wgid = (xcd < r ? xcd * (q + 1) : r * (q + 1) + (xcd - r) * q) + off; }
        const int nig = WGM * nN, gid = wgid / nig, fm = gid * WGM, gsz = (nM - fm) < WGM ? (nM - fm) : WGM;
        const int pm = fm + ((wgid % nig) % gsz), pnl = (wgid % nig) / gsz;
        const int e = (pm >= t1) + (pm >= t2) + (pm >= t3) + (pm >= t4) + (pm >= t5) + (pm >= t6) + (pm >= t7);
        const int tb = e == 0 ? 0 : e == 1 ? t1 : e == 2 ? t2 : e == 3 ? t3 : e == 4 ? t4 : e == 5 ? t5 : e == 6 ? t6 : t7;
        u.pm = pm; u.pn = e * nN + pnl; u.ks = 0; u.lo = e * 16384 + (pm - tb) * 256; return true;
    }
    __device__ __forceinline__ void a_ready(const Unit&) const {}
    __device__ __forceinline__ void done(const Unit&) const {}
};
#ifndef FP8_DEBUG_NONSCALED
#define FP8_DEBUG_NONSCALED 0
#endif
template <class Epi, class Sched, bool ALIGN_EPI = false, bool SP2 = false, int FP8 = 0, bool AIND = false>
__device__ __forceinline__ void gemm_phase(PG8_LAS unsigned char* lds, const Gemm g, const Sched S, const Epi E) {
    const int tid = threadIdx.x, wid = __builtin_amdgcn_readfirstlane(tid >> 6), lane = tid & 63, wr = wid >> 2, wc = wid & 3, fr = lane & 15, fq = lane >> 4;
    const int K = g.K, nt = g.nt ? g.nt : K / BK;
    unsigned voffA[2], voffB[2];
#pragma unroll
    for (int i = 0; i < 2; ++i) { int R, C; stage_rc(tid * 16 + i * 8192, R, C); const int Rb = Epi::PERM ? ((R & ~31) + perm32(R & 31)) : R;
        voffA[i] = (unsigned)(R * K + C) * 2u; voffB[i] = (unsigned)(Rb * K + C) * 2u; }
    const size_t kstep = (size_t)(BK * 2);
    const size_t hstep = (size_t)HALF * K * 2;
    const size_t hstepA = AIND ? (size_t)0 : hstep;
    unsigned cvo[2][2];
#pragma unroll
    for (int h = 0; h < 2; ++h)
#pragma unroll
        for (int i = 0; i < 2; ++i) cvo[h][i] = voffA[i];
    PG8_LAS unsigned char* rtab = lds + STAGE_BYTES + 4096;
#define PG8_RT_FILL(slot, un) do { __builtin_amdgcn_global_load_lds((const unsigned*)(g.rowlist + (un).lo + (wid & 3) * 64 + lane), (PG8_LAS unsigned*)(rtab + (slot) * 1024 + (wid & 3) * 256), 4, 0, 0); } while (0)
#define PG8_RT_OFFS(slot) do { _Pragma("unroll") for (int h_ = 0; h_ < 2; ++h_) _Pragma("unroll") for (int i_ = 0; i_ < 2; ++i_) { int R_, C_; stage_rc(tid * 16 + i_ * 8192, R_, C_); \
        unsigned tk_ = *(const PG8_LAS unsigned*)(rtab + (slot) * 1024 + 4 * (128 * h_ + R_)); tk_ = tk_ < (unsigned)g.rowmax ? tk_ : (unsigned)g.rowmax; cvo[h_][i_] = tk_ * (unsigned)(K * 2) + (unsigned)C_ * 2u; } } while (0)
    const size_t tstep = 2 * hstep;
    const unsigned ldsw = (unsigned)wid * 1024u;
    const int aoff = lds_byte(wr * 64 + fr, fq * 8), boff = lds_byte(wc * 32 + fr, fq * 8);
#define PG8_SA(b, h) (((b) * 2 + (h)) * HTB)
#define PG8_SB(b, h) ((4 + (b) * 2 + (h)) * HTB)
#define PG8_STAGE(bufoff, gbase, voff) do { _Pragma("unroll") for (int _i = 0; _i < 2; ++_i) \
        __builtin_amdgcn_global_load_lds((const unsigned*)((const char*)(gbase) + (voff)[_i]), (PG8_LAS unsigned*)(lds + (bufoff) + ldsw + _i * 8192), 16, 0, 0); } while (0)
#define PG8_STAGE_A(bufoff, gbase, H) PG8_STAGE(bufoff, (gbase) + (H) * hstepA, cvo[H])
#define PG8_CAT(p0) __builtin_shufflevector(*(const PG8_LAS v4i_t*)(p0), *(const PG8_LAS v4i_t*)((p0) + 1024), 0, 1, 2, 3, 4, 5, 6, 7)
#define PG8_LO(x) __builtin_bit_cast(bf16x8, __builtin_shufflevector((x), (x), 0, 1, 2, 3))
#define PG8_HI(x) __builtin_bit_cast(bf16x8, __builtin_shufflevector((x), (x), 4, 5, 6, 7))
#define PG8_LDA(dst, b, h) do { _Pragma("unroll") for (int m = 0; m < 4; ++m) dst[m] = PG8_CAT(lds + PG8_SA(b, h) + aoff + m * 2048); } while (0)
#define PG8_LDB(dst, b, h) do { _Pragma("unroll") for (int n = 0; n < 2; ++n) dst[n] = PG8_CAT(lds + PG8_SB(b, h) + boff + n * 2048); } while (0)
#define PG8_MMA(ai, bj, At, Bt) do { __builtin_amdgcn_s_setprio(1); \
        if constexpr (FP8 == 2) { _Pragma("unroll") for (int m = 0; m < 4; ++m) _Pragma("unroll") for (int n = 0; n < 2; ++n) { \
            v4i_t c_ = __builtin_bit_cast(v4i_t, acc[ai][bj][m][n]); \
            c_ = __builtin_amdgcn_mfma_i32_16x16x64_i8(__builtin_shufflevector(Bt[n], Bt[n], 0, 1, 2, 3), __builtin_shufflevector(At[m], At[m], 0, 1, 2, 3), c_, 0, 0, 0); \
            c_ = __builtin_amdgcn_mfma_i32_16x16x64_i8(__builtin_shufflevector(Bt[n], Bt[n], 4, 5, 6, 7), __builtin_shufflevector(At[m], At[m], 4, 5, 6, 7), c_, 0, 0, 0); \
            acc[ai][bj][m][n] = __builtin_bit_cast(f32x4, c_); } } \
        else if constexpr (FP8 == 1) { _Pragma("unroll") for (int m = 0; m < 4; ++m) _Pragma("unroll") for (int n = 0; n < 2; ++n) { \
            if (FP8_DEBUG_NONSCALED) { _Pragma("unroll") for (int q = 0; q < 4; ++q) { \
                const long ba = (long)(((unsigned long long)(unsigned)Bt[n][2 * q + 1] << 32) | (unsigned)Bt[n][2 * q]), aa = (long)(((unsigned long long)(unsigned)At[m][2 * q + 1] << 32) | (unsigned)At[m][2 * q]); \
                acc[ai][bj][m][n] = __builtin_amdgcn_mfma_f32_16x16x32_fp8_fp8(ba, aa, acc[ai][bj][m][n], 0, 0, 0); } } \
            else asm volatile("v_mfma_scale_f32_16x16x128_f8f6f4 %0, %1, %2, %0, %3, %3 op_sel_hi:[0,0,0]" : "+v"(acc[ai][bj][m][n]) : "v"(Bt[n]), "v"(At[m]), "v"(sc1)); } } \
        else { _Pragma("unroll") for (int m = 0; m < 4; ++m) _Pragma("unroll") for (int n = 0; n < 2; ++n) { \
            acc[ai][bj][m][n] = __builtin_amdgcn_mfma_f32_16x16x32_bf16(PG8_LO(Bt[n]), PG8_LO(At[m]), acc[ai][bj][m][n], 0, 0, 0); \
            acc[ai][bj][m][n] = __builtin_amdgcn_mfma_f32_16x16x32_bf16(PG8_HI(Bt[n]), PG8_HI(At[m]), acc[ai][bj][m][n], 0, 0, 0); } } \
        __builtin_amdgcn_s_setprio(0); } while (0)
#define PG8_WAIT_V(n) asm volatile("s_waitcnt vmcnt(" #n ")" ::: "memory")
#define PG8_WAIT_L(n) asm volatile("s_waitcnt lgkmcnt(" #n ")" ::: "memory")
#define PG8_BAR __builtin_amdgcn_s_barrier()
#define PG8_SCHED __builtin_amdgcn_sched_barrier(0)
    Unit cur, nxt; int ui = 0;
    if (!S.next(0, cur)) return;
    f32x4 acc[2][2][4][2];
#pragma unroll
    for (int a = 0; a < 2; ++a)
#pragma unroll
        for (int b = 0; b < 2; ++b)
#pragma unroll
            for (int m = 0; m < 4; ++m)
#pragma unroll
                for (int n = 0; n < 2; ++n) acc[a][b][m][n] = (f32x4){0.f, 0.f, 0.f, 0.f};
    v8i_t At[4], B0[2], B1[2];
    const unsigned sc1 = 0x7f7f7f7fu;
    const size_t sstep = (size_t)nt * (BK * 2);
    const char* cA = (const char*)g.A + (AIND ? (size_t)0 : (size_t)cur.pm * tstep) + (size_t)cur.ks * sstep; const char* cB = (const char*)g.Bt + (size_t)cur.pn * tstep + (size_t)cur.ks * sstep;
    S.a_ready(cur);
    if constexpr (AIND) { PG8_RT_FILL(0, cur); PG8_WAIT_V(0); PG8_BAR; PG8_RT_OFFS(0); }
    if constexpr (SP2) {
        PG8_STAGE(PG8_SB(0, 0), cB, voffB); PG8_STAGE(PG8_SB(0, 1), cB + hstep, voffB); PG8_STAGE_A(PG8_SA(0, 0), cA, 0); PG8_STAGE_A(PG8_SA(0, 1), cA, 1);
        if (wr == 1) PG8_BAR;
        PG8_WAIT_V(2); PG8_BAR;
        PG8_STAGE(PG8_SB(1, 0), cB + kstep, voffB); PG8_STAGE_A(PG8_SA(1, 0), cA + kstep, 0); PG8_STAGE(PG8_SB(1, 1), cB + hstep + kstep, voffB);
        PG8_WAIT_V(6); PG8_BAR;
    } else {
        PG8_STAGE(PG8_SB(0, 0), cB, voffB); PG8_STAGE_A(PG8_SA(0, 0), cA, 0); PG8_STAGE(PG8_SB(0, 1), cB + hstep, voffB); PG8_STAGE_A(PG8_SA(0, 1), cA, 1);
        if (wr == 1) PG8_BAR;
        PG8_WAIT_V(4); PG8_BAR;
        PG8_STAGE(PG8_SB(1, 0), cB + kstep, voffB); PG8_STAGE_A(PG8_SA(1, 0), cA + kstep, 0); PG8_STAGE(PG8_SB(1, 1), cB + hstep + kstep, voffB);
        PG8_WAIT_V(6); PG8_BAR;
    }
    for (;;) {
        const bool has_next = S.next(ui + 1, nxt);
        if constexpr (AIND) { if (has_next) PG8_RT_FILL((ui + 1) & 1, nxt); }
        const char* nA = has_next ? (const char*)g.A + (AIND ? (size_t)0 : (size_t)nxt.pm * tstep) + (size_t)nxt.ks * sstep : cA; const char* nB = has_next ? (const char*)g.Bt + (size_t)nxt.pn * tstep + (size_t)nxt.ks * sstep : cB;
#pragma clang loop unroll(disable)
        for (int t = 0; t < nt; t += 2) {
            const bool last = (t == nt - 2);
            const char* a1 = cA + (size_t)(t + 1) * kstep;
            const char* a2 = last ? nA : cA + (size_t)(t + 2) * kstep; const char* b2 = last ? nB : cB + (size_t)(t + 2) * kstep;
            const char* a3 = a2 + kstep; const char* b3 = b2 + kstep;
            if (last && has_next) S.a_ready(nxt);
            if constexpr (SP2) {
            PG8_LDB(B0, 0, 0); PG8_LDB(B1, 0, 1); PG8_SCHED; PG8_LDA(At, 0, 0); PG8_STAGE_A(PG8_SA(1, 1), a1, 1);
            if constexpr (AIND) { if (last && has_next) PG8_RT_OFFS((ui + 1) & 1); }
            PG8_WAIT_V(8); PG8_WAIT_L(0); PG8_BAR; PG8_MMA(0, 0, At, B0); PG8_MMA(0, 1, At, B1); PG8_BAR; PG8_SCHED;
            PG8_LDA(At, 0, 1); PG8_STAGE(PG8_SB(0, 0), b2, voffB); PG8_STAGE(PG8_SB(0, 1), b2 + hstep, voffB); PG8_STAGE_A(PG8_SA(0, 0), a2, 0);
            PG8_WAIT_V(8); PG8_WAIT_L(0); PG8_BAR; PG8_MMA(1, 0, At, B0); PG8_MMA(1, 1, At, B1); PG8_BAR; PG8_SCHED;
            PG8_LDB(B0, 1, 0); PG8_LDB(B1, 1, 1); PG8_SCHED; PG8_LDA(At, 1, 0); PG8_STAGE_A(PG8_SA(0, 1), a2, 1);
            PG8_WAIT_V(8); PG8_WAIT_L(0); PG8_BAR; PG8_MMA(0, 0, At, B0); PG8_MMA(0, 1, At, B1); PG8_BAR; PG8_SCHED;
            PG8_LDA(At, 1, 1); PG8_STAGE(PG8_SB(1, 0), b3, voffB); PG8_STAGE(PG8_SB(1, 1), b3 + hstep, voffB); PG8_STAGE_A(PG8_SA(1, 0), a3, 0);
            PG8_WAIT_V(8); PG8_WAIT_L(0); PG8_BAR; PG8_MMA(1, 0, At, B0); PG8_MMA(1, 1, At, B1); PG8_BAR; PG8_SCHED;
            } else {
            PG8_LDB(B0, 0, 0); PG8_SCHED; PG8_LDA(At, 0, 0); PG8_STAGE_A(PG8_SA(1, 1), a1, 1);
            if constexpr (AIND) { if (last && has_next) PG8_RT_OFFS((ui + 1) & 1); }
            PG8_WAIT_L(8); PG8_BAR; PG8_WAIT_L(0); PG8_MMA(0, 0, At, B0); PG8_BAR; PG8_SCHED;
            PG8_LDB(B1, 0, 1); PG8_STAGE(PG8_SB(0, 0), b2, voffB);
            PG8_BAR; PG8_WAIT_L(0); PG8_MMA(0, 1, At, B1); PG8_BAR;
            PG8_LDA(At, 0, 1); PG8_STAGE_A(PG8_SA(0, 0), a2, 0);
            PG8_BAR; PG8_WAIT_L(0); PG8_MMA(1, 0, At, B0); PG8_BAR; PG8_SCHED;
            PG8_STAGE(PG8_SB(0, 1), b2 + hstep, voffB);
            PG8_WAIT_V(6); PG8_BAR; PG8_MMA(1, 1, At, B1); PG8_BAR;
            PG8_LDB(B0, 1, 0); PG8_SCHED; PG8_LDA(At, 1, 0); PG8_STAGE_A(PG8_SA(0, 1), a2, 1);
            PG8_WAIT_L(8); PG8_BAR; PG8_WAIT_L(0); PG8_MMA(0, 0, At, B0); PG8_BAR; PG8_SCHED;
            PG8_LDB(B1, 1, 1); PG8_STAGE(PG8_SB(1, 0), b3, voffB);
            PG8_BAR; PG8_WAIT_L(0); PG8_MMA(0, 1, At, B1); PG8_BAR;
            PG8_LDA(At, 1, 1); PG8_STAGE_A(PG8_SA(1, 0), a3, 0);
            PG8_BAR; PG8_WAIT_L(0); PG8_MMA(1, 0, At, B0); PG8_BAR; PG8_SCHED;
            PG8_STAGE(PG8_SB(1, 1), b3 + hstep, voffB);
            PG8_WAIT_V(6); PG8_BAR; PG8_MMA(1, 1, At, B1); PG8_BAR;
            }
        }
        if constexpr (FP8 == 1) asm volatile("s_nop 15\n\ts_nop 15" ::: "memory");
        if constexpr (ALIGN_EPI) { if (wr == 0) PG8_BAR; }
        if constexpr (!Epi::AFTER_DRAIN) { E(acc, cur, wr, wc, fr, fq); S.done(cur); }
        if (!has_next) break;
#pragma unroll
        for (int a = 0; a < 2; ++a)
#pragma unroll
            for (int b = 0; b < 2; ++b)
#pragma unroll
                for (int m = 0; m < 4; ++m)
#pragma unroll
                    for (int n = 0; n < 2; ++n) acc[a][b][m][n] = (f32x4){0.f, 0.f, 0.f, 0.f};
        cur = nxt; cA = nA; cB = nB; ++ui;
        if constexpr (ALIGN_EPI) { if (wr == 1) PG8_BAR; }
    }
    PG8_WAIT_V(0);
    if constexpr (!ALIGN_EPI) { if (wr == 0) PG8_BAR; }
    PG8_BAR;
    if constexpr (Epi::AFTER_DRAIN) { E.fused(acc, cur, wr, wc, fr, fq, lds, wid, lane); S.done(cur); }
#undef PG8_SA
#undef PG8_SB
#undef PG8_STAGE
#undef PG8_CAT
#undef PG8_LO
#undef PG8_HI
#undef PG8_STAGE_A
#undef PG8_RT_FILL
#undef PG8_RT_OFFS
#undef PG8_LDA
#undef PG8_LDB
#undef PG8_MMA
#undef PG8_WAIT_V
#undef PG8_WAIT_L
#undef PG8_BAR
#undef PG8_SCHED
}
}
#define GAS __attribute__((address_space(1)))
#define LAS __attribute__((address_space(3)))
typedef unsigned short bf16;
typedef unsigned v4u __attribute__((ext_vector_type(4)));
typedef float f32x4 __attribute__((ext_vector_type(4)));
typedef short bf16x8 __attribute__((ext_vector_type(8)));
typedef GAS unsigned gu32;
typedef GAS unsigned long long gu64;
#define RLX_AGENT __ATOMIC_RELAXED, __HIP_MEMORY_SCOPE_AGENT
#define LDS_WAIT() asm volatile("s_waitcnt lgkmcnt(0)" ::: "memory")
#define VM_WAIT() asm volatile("s_waitcnt vmcnt(0)" ::: "memory")
__device__ __forceinline__ unsigned long long rt() { return __builtin_amdgcn_s_memrealtime(); }
__device__ __forceinline__ unsigned f2bf(float f) { unsigned u = __builtin_bit_cast(unsigned, f); return (u + 0x7fffu + ((u >> 16) & 1u)) >> 16; }
__device__ __forceinline__ unsigned pk2(float lo, float hi) { return f2bf(lo) | (f2bf(hi) << 16); }

#define XB_TMO      128
#define XB_XCNT(j)  (256  + 64 * (j))
#define XB_XSUB(j)  (1280 + 64 * (j))
#define XB_XGEN(j)  (2304 + 64 * (j))
#define XB_TOP      3328
#define XB_TOPGEN   3392
#define XCD_BAR_WORDS 3456
#define XB_SPIN_CAP (1u << 18)

__device__ __forceinline__ unsigned xb_ld(unsigned* p)              { return __hip_atomic_load(p, __ATOMIC_RELAXED, __HIP_MEMORY_SCOPE_AGENT); }
__device__ __forceinline__ unsigned xb_add(unsigned* p, unsigned v) { return __hip_atomic_fetch_add(p, v, __ATOMIC_RELAXED, __HIP_MEMORY_SCOPE_AGENT); }
__device__ __forceinline__ unsigned xb_xcc_id() { return (unsigned)__builtin_amdgcn_s_getreg((3 << 11) | 20) & 0xFu; }
#define XB_SPIN(cond, bar) do { unsigned _sp = 0; while (cond) { __builtin_amdgcn_s_sleep(1); \
    if ((++_sp & 255u) == 0u) { if (xb_ld(&(bar)[XB_TMO])) break; if (_sp > XB_SPIN_CAP) { atomicAdd(&(bar)[XB_TMO], 1u); break; } } } } while (0)

struct XcdBarrier {
    unsigned* bar; unsigned x;
    volatile LAS unsigned* st;
};

__device__ __forceinline__ XcdBarrier xcd_barrier_post(unsigned* bar, volatile LAS unsigned* st) {
    XcdBarrier b; b.bar = bar; b.x = xb_xcc_id(); b.st = st;
    if (threadIdx.x == 0) (void)xb_add(&bar[XB_XCNT(b.x)], 1u);
    return b;
}
__device__ __forceinline__ void xcd_barrier_complete(unsigned* bar, unsigned x, unsigned& nloc, unsigned& nx) {
    const unsigned G = gridDim.x * gridDim.y * gridDim.z;
    unsigned sum, cnt, mine, sp = 0u;
    for (;;) {
        sum = 0u; cnt = 0u; mine = 0u;
#pragma unroll
        for (unsigned j = 0; j < 16; ++j) { const unsigned c = xb_ld(&bar[XB_XCNT(j)]); sum += c; cnt += (c > 0u) ? 1u : 0u; mine = (j == x) ? c : mine; }
        if (sum == G) break;
        __builtin_amdgcn_s_sleep(1);
        if ((++sp & 255u) == 0u) { if (xb_ld(&bar[XB_TMO])) break; if (sp > XB_SPIN_CAP) { atomicAdd(&bar[XB_TMO], 1u); break; } }
    }
    nloc = mine > 0u ? mine : 1u; nx = cnt > 0u ? cnt : 1u;
}

__device__ __forceinline__ void xcd_barrier(const XcdBarrier& b) {
    asm volatile("s_waitcnt vmcnt(0)" ::: "memory");
    __syncthreads();
    if (threadIdx.x == 0) {
        unsigned* bar = b.bar;
        __builtin_amdgcn_s_waitcnt(0);
        unsigned nloc = b.st[0], nx = b.st[1];
        if (nloc == 0u) { xcd_barrier_complete(bar, b.x, nloc, nx); b.st[0] = nloc; b.st[1] = nx; }
        const unsigned old = xb_add(&bar[XB_XSUB(b.x)], 1u);
        const unsigned gen = old / nloc;
        if (old + 1u == (gen + 1u) * nloc) {
            __builtin_amdgcn_fence(__ATOMIC_RELEASE, "agent");
            asm volatile("s_waitcnt vmcnt(0)" ::: "memory");
            const unsigned og = xb_add(&bar[XB_TOP], 1u);
            const unsigned tg = og / nx;
            if (og + 1u == (tg + 1u) * nx) xb_add(&bar[XB_TOPGEN], 1u);
            else XB_SPIN(xb_ld(&bar[XB_TOPGEN]) == tg, bar);
            __builtin_amdgcn_fence(__ATOMIC_ACQUIRE, "agent");
            xb_add(&bar[XB_XGEN(b.x)], 1u);
            asm volatile("s_waitcnt vmcnt(0)" ::: "memory");
        } else {
            XB_SPIN(xb_ld(&bar[XB_XGEN(b.x)]) == gen, bar);
            __builtin_amdgcn_fence(__ATOMIC_ACQUIRE, "agent");
            asm volatile("s_waitcnt vmcnt(0)" ::: "memory");
        }
    }
    __syncthreads();
}

constexpr int NWAVES = 8, NTHR = 512;
constexpr int T = 16384, D = 1024, SEQ = 4096, NB = 4;
constexpr int FF = 2816, FFE = 3584, NE = 8;
constexpr int NKVQ = 9216;
constexpr float EPS = 1e-6f;
constexpr float QSCALE = 0.125f * 1.4426950408889634f;
constexpr size_t MiB = 1u << 20;
constexpr size_t WS_CTL = 0, CTL_ZERO_BYTES = 64 * 1024;
constexpr size_t WS_TAB = 2 * MiB;
constexpr size_t WS_COS = WS_TAB, WS_SIN = WS_TAB + 512 * 1024, WS_LB = WS_TAB + 1 * MiB, WS_SS0 = WS_LB + 64 * 1024, WS_SS3 = WS_SS0 + 64 * 1024;
constexpr size_t WS_TOKE = WS_TAB + 1 * MiB + 256 * 1024, WS_TOKP = WS_TOKE + 128 * 1024, WS_TOKW = WS_TOKP + 128 * 1024, WS_TOKD = WS_TOKW + 128 * 1024;
constexpr size_t WS_SSS = WS_TOKD + 128 * 1024  , WS_WSORT = WS_TAB + 2 * MiB, WS_DECAY = WS_TAB + 3 * MiB  ;
constexpr size_t WS_SS1 = WS_TAB + 4 * MiB, WS_SS2 = WS_TAB + 5 * MiB;
constexpr size_t WS_QZVG = 8 * MiB;
constexpr size_t WS_KVT = 136 * MiB;
constexpr size_t WS_ST = 200 * MiB;
constexpr size_t WS_OH = 264 * MiB;
constexpr size_t WS_ACTF = 8 * MiB;
constexpr size_t WS_KVQ = 8 * MiB;
constexpr size_t WS_OA = 296 * MiB;
constexpr size_t WS_LSE = 392 * MiB;
constexpr size_t WS_WGU = 8 * MiB;
constexpr size_t WS_WD = 64 * MiB;
constexpr size_t WS_ASORT = 92 * MiB;
constexpr size_t WS_Y = 126 * MiB;
constexpr size_t WS_ACTM = 194 * MiB;
constexpr float I8_SA = 21.0f  , I8_SW = 880.f  ;
constexpr float FP8_SA = 16.f, FP8_SW1 = 64.f, FP8_SACT = 8.f, FP8_SW2 = 128.f;
constexpr size_t WS_WS = 400 * MiB;
constexpr size_t WS_WIN = WS_WS, WS_WOH = WS_WIN + 8 * MiB, WS_WFGU = WS_WOH + 2 * MiB, WS_WFD = WS_WFGU + 11 * MiB, WS_WKVQ = WS_WFD + 6 * MiB, WS_WOD = WS_WKVQ + 18 * MiB;
constexpr size_t WS_HB = 448 * MiB;
constexpr size_t WS_END = 482 * MiB;
static_assert(WS_SS2 + 1 * MiB <= WS_QZVG && WS_WOD + 2 * MiB <= WS_HB && WS_ACTM + (size_t)34816 * 3584 <= WS_WS && WS_LSE + 3 * MiB <= WS_WS, "ws map");
constexpr int MAXROWS = 34816, PART_ROWS = 2048;

constexpr int CW_TMO = 0, CW_CODE = 1, CW_BAR = 1024  , CW_CNT = 8192;
static_assert((CW_BAR + 2 * 3456) <= CW_CNT && (CW_CNT + 8 * 64) * 4 <= (int)CTL_ZERO_BYTES, "every control word lies inside the per-call memset");

constexpr int RING_OFF = 0, RING_BYTES = 131072;
constexpr int LDSCTL_OFF = RING_BYTES, MISC_OFF = LDSCTL_OFF + 320;
constexpr int LDS_BYTES = 147456;

__device__ __forceinline__ float bf2f(unsigned short b) { return __uint_as_float(((unsigned)b) << 16); }
__device__ __forceinline__ float bflo(unsigned w) { return __uint_as_float(w << 16); }
__device__ __forceinline__ float bfhi(unsigned w) { return __uint_as_float(w & 0xffff0000u); }
__device__ __forceinline__ float wave_sum(float v) {
#pragma unroll
    for (int o = 1; o < 64; o <<= 1) v += __shfl_xor(v, o);
    return v;
}
__device__ __forceinline__ float wave_max(float v) {
#pragma unroll
    for (int o = 1; o < 64; o <<= 1) v = fmaxf(v, __shfl_xor(v, o));
    return v;
}

__device__ __forceinline__ void transpose_item(const float* W, int ldw, int K, const float* gain, bf16* WT, int map, int row_off, LAS float* scr, int kb, int nb, int lane) {
    const int k0 = 64 * kb, n0 = 32 * nb;
    float wv[32];
#pragma unroll
    for (int i = 0; i < 32; ++i) { const int kk = 2 * i + (lane >> 5); wv[i] = W[(size_t)(k0 + kk) * ldw + n0 + (lane & 31)]; }
#pragma unroll
    for (int i = 0; i < 32; ++i) { const int kk = 2 * i + (lane >> 5); const float gk = gain ? gain[k0 + kk] : 1.0f; scr[kk * 33 + (lane & 31)] = wv[i] * gk; }
    LDS_WAIT(); asm volatile("" ::: "memory");
    const int c = lane & 7;
#pragma unroll
    for (int j = 0; j < 4; ++j) { const int n = (lane >> 3) + 8 * j; const LAS float* s = scr + (8 * c) * 33 + n;
        v4u o; o.x = pk2(s[0 * 33], s[1 * 33]); o.y = pk2(s[2 * 33], s[3 * 33]); o.z = pk2(s[4 * 33], s[5 * 33]); o.w = pk2(s[6 * 33], s[7 * 33]);
        const int nn = n0 + n; int dr = nn;
        if (map == 1) dr = ((nn >> 7) << 8) + (nn & 127);
        if (map == 2) { const int d = nn & 63; dr = (nn & ~63) + 8 * ((d & 31) >> 2) + 4 * (d >> 5) + (d & 3); }
        *(GAS v4u*)(WT + (size_t)(row_off + dr) * K + k0 + 8 * c) = o; }
    LDS_WAIT(); asm volatile("" ::: "memory");
}


typedef short s16x4 __attribute__((ext_vector_type(4)));
typedef float f32x16 __attribute__((ext_vector_type(16)));
typedef float f32x2_t __attribute__((ext_vector_type(2)));
typedef __bf16 bf16x2_t __attribute__((ext_vector_type(2)));
typedef short v4i16_t __attribute__((ext_vector_type(4)));
#define MFMA32(a, b, c) __builtin_amdgcn_mfma_f32_32x32x16_bf16((a), (b), (c), 0, 0, 0)
__device__ __forceinline__ unsigned cvtpk(float lo, float hi) { f32x2_t v = {lo, hi}; bf16x2_t b = __builtin_convertvector(v, bf16x2_t); return __builtin_bit_cast(unsigned, b); }
__device__ __forceinline__ int crow(int r, int hi) { return (r & 3) + 8 * (r >> 2) + 4 * hi; }
__device__ __forceinline__ s16x4 trd(const LAS char* p) { return __builtin_bit_cast(s16x4, __builtin_amdgcn_ds_read_tr16_b64_v4i16((LAS v4i16_t*)p)); }
__device__ __forceinline__ bf16x8 trpair(const LAS char* p0, const LAS char* p1) { const s16x4 lo = trd(p0), hi = trd(p1); return __builtin_shufflevector(lo, hi, 0, 1, 2, 3, 4, 5, 6, 7); }
#define PACK8(x, s) __builtin_bit_cast(bf16x8, (v4u){cvtpk((x)[8 * (s)], (x)[8 * (s) + 1]), cvtpk((x)[8 * (s) + 2], (x)[8 * (s) + 3]), cvtpk((x)[8 * (s) + 4], (x)[8 * (s) + 5]), cvtpk((x)[8 * (s) + 6], (x)[8 * (s) + 7])})

__device__ __forceinline__ void transpose_item8(const float* W, int ldw, int K, const float* gain, float scale, unsigned char* WT, int map, int row_off, LAS float* scr, int kb, int nb, int lane) {
    const int k0 = 64 * kb, n0 = 32 * nb;
    float wv[32];
#pragma unroll
    for (int i = 0; i < 32; ++i) { const int kk = 2 * i + (lane >> 5); wv[i] = W[(size_t)(k0 + kk) * ldw + n0 + (lane & 31)]; }
#pragma unroll
    for (int i = 0; i < 32; ++i) { const int kk = 2 * i + (lane >> 5); const float gk = gain ? gain[k0 + kk] * scale : scale; scr[kk * 33 + (lane & 31)] = wv[i] * gk; }
    LDS_WAIT(); asm volatile("" ::: "memory");
    const int c = lane & 3;
#pragma unroll
    for (int j = 0; j < 2; ++j) { const int n = (lane >> 2) + 16 * j; const LAS float* s = scr + (16 * c) * 33 + n;
        v4u o; o.x = pg8::pk4_fp8(s[0 * 33], s[1 * 33], s[2 * 33], s[3 * 33]); o.y = pg8::pk4_fp8(s[4 * 33], s[5 * 33], s[6 * 33], s[7 * 33]);
        o.z = pg8::pk4_fp8(s[8 * 33], s[9 * 33], s[10 * 33], s[11 * 33]); o.w = pg8::pk4_fp8(s[12 * 33], s[13 * 33], s[14 * 33], s[15 * 33]);
        const int nn = n0 + n; int dr = nn;
        if (map == 1) dr = ((nn >> 7) << 8) + (nn & 127);
        if (map == 2) { const int d = nn & 63; dr = (nn & ~63) + 8 * ((d & 31) >> 2) + 4 * (d >> 5) + (d & 3); }
        *(GAS v4u*)(WT + (size_t)(row_off + dr) * K + k0 + 16 * c) = o; }
    LDS_WAIT(); asm volatile("" ::: "memory");
}

__device__ __forceinline__ void transpose_item_i8(const float* W, int ldw, int K, const float* gain, float scale, unsigned char* WT, int map, int row_off, LAS float* scr, int kb, int nb, int lane) {
    const int k0 = 64 * kb, n0 = 32 * nb;
    float wv[32];
#pragma unroll
    for (int i = 0; i < 32; ++i) { const int kk = 2 * i + (lane >> 5); wv[i] = W[(size_t)(k0 + kk) * ldw + n0 + (lane & 31)]; }
#pragma unroll
    for (int i = 0; i < 32; ++i) { const int kk = 2 * i + (lane >> 5); const float gk = gain ? gain[k0 + kk] * scale : scale; scr[kk * 33 + (lane & 31)] = wv[i] * gk; }
    LDS_WAIT(); asm volatile("" ::: "memory");
    const int c = lane & 3;
#pragma unroll
    for (int j = 0; j < 2; ++j) { const int n = (lane >> 2) + 16 * j; const LAS float* s = scr + (16 * c) * 33 + n;
        v4u o; o.x = pg8::pk4_i8(s[0 * 33], s[1 * 33], s[2 * 33], s[3 * 33]); o.y = pg8::pk4_i8(s[4 * 33], s[5 * 33], s[6 * 33], s[7 * 33]);
        o.z = pg8::pk4_i8(s[8 * 33], s[9 * 33], s[10 * 33], s[11 * 33]); o.w = pg8::pk4_i8(s[12 * 33], s[13 * 33], s[14 * 33], s[15 * 33]);
        const int nn = n0 + n; int dr = nn;
        if (map == 1) dr = ((nn >> 7) << 8) + (nn & 127);
        *(GAS v4u*)(WT + (size_t)(row_off + dr) * K + k0 + 16 * c) = o; }
    LDS_WAIT(); asm volatile("" ::: "memory");
}

struct Args { const float* in[19]; float* out; unsigned char* ws; int ph_lo, ph_hi, li, pad; };
constexpr int NPHASE = 17;

__global__ void __launch_bounds__(NTHR, 2) fwd_kernel(Args args) {
    extern __shared__ __attribute__((aligned(16))) unsigned char lds_raw[];
    LAS unsigned char* lds = (LAS unsigned char*)lds_raw;
    volatile LAS unsigned* MISC = (volatile LAS unsigned*)(lds + MISC_OFF);
    const int tid = threadIdx.x, lane = tid & 63, wave = __builtin_amdgcn_readfirstlane(tid >> 6);
    const int G = gridDim.x, bid = blockIdx.x;
    const int gw = bid * NWAVES + wave, NGW = G * NWAVES;
#define ctl ((gu32*)(args.ws + WS_CTL))
    const int lo = args.ph_lo, hi = args.ph_hi;
    for (int u = tid; u < (LDS_BYTES - LDSCTL_OFF) / 4; u += NTHR) ((LAS unsigned*)(lds + LDSCTL_OFF))[u] = 0u;
    __syncthreads();
    XcdBarrier bar; bar.bar = (unsigned*)(ctl + CW_BAR) + args.li * XCD_BAR_WORDS; bar.x = 0; bar.st = nullptr;
    if (hi - lo > 1) bar = xcd_barrier_post((unsigned*)(ctl + CW_BAR) + args.li * XCD_BAR_WORDS, MISC + 8);
#define IN(k) (lo <= (k) && (k) < hi)
#if defined(PROBE_NOSTORE)
#define PROBE_SKIP(k) ((args.li == 1 && lo == (k)) ? 1 : 0)
#else
#define PROBE_SKIP(k) 0
#endif
#define SEAM(k) do { if (IN(k) && IN((k) + 1)) xcd_barrier(bar); } while (0)
#define RSTD_TABLE(S_, ssptr_, slots_) LAS float* rsl_ = (LAS float*)(lds + LDSCTL_OFF + 2048); const unsigned rsl = (unsigned)(size_t)rsl_; int pml = -1; { pg8::Unit u0_; if (S_.next(0, u0_)) pml = u0_.pm; \
        if (pml >= 0 && tid < 256) { const int row_ = pml * 256 + tid; const float ssv_ = (slots_) ? pg8::row_ss<true>(ssptr_, row_) : pg8::row_ss<false>(ssptr_, row_); rsl_[tid] = __builtin_amdgcn_rsqf(ssv_ * (1.0f / 1024.0f) + EPS); } \
        __syncthreads(); }
#ifndef F8_SP2
#define F8_SP2 true
#endif
#ifndef MOE_ALIGN
#define MOE_ALIGN true
#endif
#ifndef STAGGER_TICKS
#define STAGGER_TICKS 0
#endif
#ifndef STAGGER1_TICKS
#define STAGGER1_TICKS 0
#endif
#define STAGGER1() do { if (STAGGER1_TICKS) { const unsigned long long t0_ = __builtin_amdgcn_s_memrealtime(); const unsigned long long d_ = (unsigned long long)(((bid >> 3) & 3) * STAGGER1_TICKS); while (__builtin_amdgcn_s_memrealtime() - t0_ < d_) __builtin_amdgcn_s_sleep(8); } } while (0)
#define STAGGER() do { if (STAGGER_TICKS) { const unsigned long long t0_ = __builtin_amdgcn_s_memrealtime(); const unsigned long long d_ = (unsigned long long)(((bid >> 3) & 3) * STAGGER_TICKS); while (__builtin_amdgcn_s_memrealtime() - t0_ < d_) __builtin_amdgcn_s_sleep(8); } } while (0)

#define xin ((const float*)(args.in[0]))
#define attn_norm ((const float*)(args.in[1]))
#define ffn_norm ((const float*)(args.in[2]))
#define hgrn_w_in ((const float*)(args.in[3]))
#define hgrn_lb ((const float*)(args.in[4]))
#define hgrn_onorm ((const float*)(args.in[5]))
#define hgrn_w_out ((const float*)(args.in[6]))
#define kv_norm ((const float*)(args.in[7]))
#define w_kv ((const float*)(args.in[8]))
#define dil_w_q ((const float*)(args.in[9]))
#define dil_w_out ((const float*)(args.in[10]))
#define ffn_wg ((const float*)(args.in[11]))
#define ffn_wu ((const float*)(args.in[12]))
#define ffn_wd ((const float*)(args.in[13]))
#define moe_wr ((const float*)(args.in[14]))
#define moe_wg ((const float*)(args.in[15]))
#define moe_wu ((const float*)(args.in[16]))
#define moe_wd ((const float*)(args.in[17]))
#define final_norm ((const float*)(args.in[18]))
#define hf ((float*)(args.out))
#define hb ((bf16*)((bf16*)(args.ws + WS_HB)))
#define hb8 ((unsigned char*)(args.ws + WS_WIN))
#define hbi8 ((unsigned char*)(args.ws + WS_KVT))
#define W_in8 ((unsigned char*)(args.ws + WS_WIN))
#define xq8 ((unsigned char*)(args.ws + WS_KVT))
#define ypart ((bf16*)(args.ws + WS_ASORT))
#define a8tok ((unsigned char*)(args.ws + WS_ASORT))
#define rowtok ((int*)(args.ws + WS_ASORT + 20 * MiB))
#define W_od8 ((unsigned char*)(args.ws + WS_WOD))
#define oa8 ((unsigned char*)(args.ws + WS_LSE + 3 * MiB))
#define W_kvq8 ((unsigned char*)(args.ws + WS_WKVQ))
#define W_fgu8 ((unsigned char*)(args.ws + WS_WFGU))
#define W_fd8 ((unsigned char*)(args.ws + WS_WFD))
#define actf8 ((unsigned char*)(args.ws + WS_ACTF))
#define cosT ((float*)((float*)(args.ws + WS_COS)))
#define sinT ((float*)((float*)(args.ws + WS_SIN)))
#define lbv ((float*)((float*)(args.ws + WS_LB)))
#define ss0 ((float*)((float*)(args.ws + WS_SS0)))
#define ss1 ((float*)((float*)(args.ws + WS_SS1)))
#define ss2 ((float*)((float*)(args.ws + WS_SS2)))
#define ss3 ((float*)((float*)(args.ws + WS_SS3)))
#define W_in ((bf16*)((bf16*)(args.ws + WS_WIN)))
#define W_oh ((bf16*)((bf16*)(args.ws + WS_WOH)))
#define W_fgu ((bf16*)((bf16*)(args.ws + WS_WFGU)))
#define W_fd ((bf16*)((bf16*)(args.ws + WS_WFD)))
#define W_kvq ((bf16*)((bf16*)(args.ws + WS_WKVQ)))
#define W_od ((bf16*)((bf16*)(args.ws + WS_WOD)))
#define W_gu ((unsigned char*)(args.ws + WS_WGU))
#define W_d ((unsigned char*)(args.ws + WS_WD))
#define qzvg ((bf16*)((bf16*)(args.ws + WS_QZVG)))
#define kvT ((bf16*)((bf16*)(args.ws + WS_KVT)))
#define stT ((bf16*)((bf16*)(args.ws + WS_ST)))
#define oh ((bf16*)((bf16*)(args.ws + WS_OH)))
#define actf ((bf16*)((bf16*)(args.ws + WS_ACTF)))
#define kvq ((bf16*)((bf16*)(args.ws + WS_KVQ)))
#define kvq8 ((const unsigned char*)(args.ws + WS_KVQ))
#define oa ((bf16*)((bf16*)(args.ws + WS_OA)))
#define asort ((unsigned char*)(args.ws + WS_ASORT))
#define actm ((unsigned char*)(args.ws + WS_ACTM))
#define ymoe ((bf16*)((bf16*)(args.ws + WS_Y)))
#define decay ((float*)((float*)(args.ws + WS_DECAY)))
#define tok_e ((int*)((int*)(args.ws + WS_TOKE)))
#define tok_p ((int*)((int*)(args.ws + WS_TOKP)))
#define tok_w ((float*)((float*)(args.ws + WS_TOKW)))
#define tok_d ((int*)((int*)(args.ws + WS_TOKD)))
#define ss_sorted ((float*)((float*)(args.ws + WS_SSS)))
#define w_sorted ((float*)((float*)(args.ws + WS_WSORT)))
    if (IN(0)) {
        LAS float* scr = (LAS float*)(lds + RING_OFF + wave * 16384);
        constexpr int I_IN = 16 * 128, I_OH = 16 * 32, I_FG = 16 * 88, I_FD = 44 * 32, I_KV = 16 * 96;
        constexpr int NIT = I_IN + I_OH + 2 * I_FG + I_FD + 3 * I_KV + I_OH;
        for (int it = gw; it < NIT; it += NGW) {
            int r = it;
            if (r < I_IN) { transpose_item(hgrn_w_in, 4096, 1024, attn_norm, W_in, 0, 0, scr, r / 128, r % 128, lane); continue; } r -= I_IN;
            if (r < I_OH) { transpose_item(hgrn_w_out, 1024, 1024, nullptr, W_oh, 0, 0, scr, r / 32, r % 32, lane); continue; } r -= I_OH;
            if (r < I_FG) { transpose_item_i8(ffn_wg, FF, 1024, ffn_norm, I8_SW, W_fgu8, 1, 0, scr, r / 88, r % 88, lane); continue; } r -= I_FG;
            if (r < I_FG) { transpose_item_i8(ffn_wu, FF, 1024, ffn_norm, I8_SW, W_fgu8, 1, 128, scr, r / 88, r % 88, lane); continue; } r -= I_FG;
            if (r < I_FD) { transpose_item(ffn_wd, 1024, FF, nullptr, W_fd, 0, 0, scr, r / 32, r % 32, lane); continue; } r -= I_FD;
            if (r < I_KV) { transpose_item8(w_kv, 6144, 1024, kv_norm, FP8_SW1, W_kvq8, 2, 0, scr, r / 96, r % 96, lane); continue; } r -= I_KV;
            if (r < I_KV) { transpose_item8(w_kv + 3072, 6144, 1024, kv_norm, FP8_SW1, W_kvq8, 0, 3072, scr, r / 96, r % 96, lane); continue; } r -= I_KV;
            if (r < I_KV) { transpose_item8(dil_w_q, 3072, 1024, attn_norm + 1024, FP8_SW1, W_kvq8, 2, 6144, scr, r / 96, r % 96, lane); continue; } r -= I_KV;
            transpose_item8(dil_w_out, 1024, 1024, nullptr, FP8_SW1, W_od8, 0, 0, scr, r / 32, r % 32, lane);
        }
        for (int m = gw; m < T; m += NGW) {
            const GAS f32x4* xr = (const GAS f32x4*)(xin + (size_t)m * D) + lane; f32x4 v[4]; float s = 0.f;
#pragma unroll
            for (int j = 0; j < 4; ++j) { v[j] = xr[64 * j]; s += (v[j].x * v[j].x + v[j].y * v[j].y) + (v[j].z * v[j].z + v[j].w * v[j].w); }
            s = wave_sum(s);
            GAS unsigned long long* o8 = (GAS unsigned long long*)(hb + (size_t)m * D) + lane;
#pragma unroll
            for (int j = 0; j < 4; ++j) o8[64 * j] = (unsigned long long)pk2(v[j].x, v[j].y) | ((unsigned long long)pk2(v[j].z, v[j].w) << 32);
            if (lane == 0) ss0[m] = s;
        }
        for (int i = bid * NTHR + tid; i < SEQ * 32; i += G * NTHR) {
            const int pos = i >> 5, j = i & 31;
            const float inv = (float)exp2(-(double)j * (13.287712379549449 / 32.0));
            const float ang = (float)pos * inv;
            const double rev = (double)ang * 0.15915494309189535; const float fr = (float)(rev - floor(rev));
            cosT[i] = __builtin_amdgcn_cosf(fr); sinT[i] = __builtin_amdgcn_sinf(fr);
        }
        for (int i = bid * NTHR + tid; i < 1024; i += G * NTHR) lbv[i] = 1.0f / (1.0f + __expf(hgrn_lb[1024 + i] - hgrn_lb[i]));
    }
    SEAM(0);
#if defined(PROBE_BARRIERS)
    if (hi - lo > 1) for (int rr = 0; rr < PROBE_BARRIERS; ++rr) xcd_barrier(bar);
#endif

    if (IN(1)) {
        pg8::Gemm g{hb, W_in, T, 4096, 1024, 0, nullptr, 0}; pg8::StaticOrder S; S.init(T, 4096, G, bid);
        RSTD_TABLE(S, ss0, false)
        pg8::EpiScale<0, false> E{qzvg, 4096, ss0, nullptr, nullptr, 1.f, PROBE_SKIP(1), 1.0f, rsl, pml};
        STAGGER();
        pg8::gemm_phase<pg8::EpiScale<0, false>, pg8::StaticOrder, true, true>(lds + RING_OFF, g, S, E);
    }
    SEAM(1);

    if (IN(2)) {
        constexpr int PB = 272;
        LAS char* kE = (LAS char*)(lds);
        LAS char* vI = (LAS char*)(lds + 17408);
        LAS float* tot = (LAS float*)(lds + 34816);
        const int dp = tid & 63, seg = tid >> 6, r32 = lane & 31, hh = lane >> 5;
        const int troff = ((lane & 15) >> 2) * PB + (16 * ((lane >> 4) & 1) + 4 * (lane & 3)) * 2;
        const int d0 = 2 * dp;
        unsigned zreg[8], vreg[8];
#define HG2_LOAD(unit_) do { const int b_ = (unit_) >> 9, h_ = ((unit_) >> 6) & 7, c_ = (unit_) & 63; const bf16* rp_ = qzvg + ((size_t)b_ * SEQ + c_ * 64 + 8 * seg) * 4096 + h_ * 128 + d0; \
            _Pragma("unroll") for (int i = 0; i < 8; ++i) { zreg[i] = *(const unsigned*)(rp_ + (size_t)i * 4096 + 1024); vreg[i] = *(const unsigned*)(rp_ + (size_t)i * 4096 + 2048); } } while (0)
        if (bid < 2048) HG2_LOAD(bid);
        for (int unit = bid; unit < 2048; unit += G) {
            const int h = (unit >> 6) & 7;
            const float lb0 = lbv[h * 128 + d0], lb1 = lbv[h * 128 + d0 + 1];
            float bl0[8], bl1[8], k0[8], k1[8]; float run0 = 1.f, run1 = 1.f;
#pragma unroll
            for (int i = 0; i < 8; ++i) { const int t = 8 * seg + i; const unsigned zz = zreg[i];
                const float e0 = __expf(-bflo(zz)), e1 = __expf(-bfhi(zz)), ri0 = __builtin_amdgcn_rcpf(1.f + e0), ri1 = __builtin_amdgcn_rcpf(1.f + e1);
                const float f0 = (1.f + lb0 * e0) * ri0, f1 = (1.f + lb1 * e1) * ri1;
                run0 *= f0; run1 *= f1; bl0[i] = run0; bl1[i] = run1; k0[i] = (1.f - lb0) * e0 * ri0; k1[i] = (1.f - lb1) * e1 * ri1;
                *(LAS unsigned*)(vI + t * PB + d0 * 2) = vreg[i]; }
            if (unit + G < 2048) HG2_LOAD(unit + G);
            tot[seg * 128 + d0] = run0; tot[seg * 128 + d0 + 1] = run1;
            __syncthreads();
            float pre0 = 1.f, pre1 = 1.f, all0 = 1.f, all1 = 1.f;
#pragma unroll
            for (int s = 0; s < 8; ++s) { const float a = tot[s * 128 + d0], bq = tot[s * 128 + d0 + 1]; all0 *= a; all1 *= bq; if (s < seg) { pre0 *= a; pre1 *= bq; } }
#pragma unroll
            for (int i = 0; i < 8; ++i) { const int t = 8 * seg + i;
                *(LAS unsigned*)(kE + t * PB + d0 * 2) = cvtpk(k0[i] * all0 * __builtin_amdgcn_rcpf(pre0 * bl0[i]), k1[i] * all1 * __builtin_amdgcn_rcpf(pre1 * bl1[i])); }
            if (seg == 0) { decay[unit * 128 + d0] = all0; decay[unit * 128 + d0 + 1] = all1; }
            __syncthreads();
            {
                const int dt = wave & 3, vt0 = 2 * (wave >> 2);
                f32x16 A0, A1;
#pragma unroll
                for (int i = 0; i < 16; ++i) { A0[i] = 0.f; A1[i] = 0.f; }
#pragma unroll
                for (int ks = 0; ks < 4; ++ks) { const int rb = (16 * ks + 8 * hh) * PB + troff;
                    const bf16x8 ka = trpair(kE + rb + 64 * dt, kE + rb + 4 * PB + 64 * dt);
                    const bf16x8 v0 = trpair(vI + rb + 64 * vt0, vI + rb + 4 * PB + 64 * vt0), v1 = trpair(vI + rb + 64 * (vt0 + 1), vI + rb + 4 * PB + 64 * (vt0 + 1));
                    A0 = MFMA32(ka, v0, A0); A1 = MFMA32(ka, v1, A1); }
                bf16* o0 = kvT + ((size_t)unit * 128 + 32 * vt0 + r32) * 128 + 32 * dt + 4 * hh;
#pragma unroll
                for (int g = 0; g < 4; ++g) {
                    *(unsigned long long*)(o0 + 8 * g) = (unsigned long long)cvtpk(A0[4 * g], A0[4 * g + 1]) | ((unsigned long long)cvtpk(A0[4 * g + 2], A0[4 * g + 3]) << 32);
                    *(unsigned long long*)(o0 + 32 * 128 + 8 * g) = (unsigned long long)cvtpk(A1[4 * g], A1[4 * g + 1]) | ((unsigned long long)cvtpk(A1[4 * g + 2], A1[4 * g + 3]) << 32); }
            }
            __syncthreads();
        }
#undef HG2_LOAD
    }
    SEAM(2);

    if (IN(3)) {
        for (int idx = bid * NTHR + tid; idx < 32 * 128 * 32; idx += G * NTHR) {
            const int bh = idx >> 12, v = (idx >> 5) & 127, dg = idx & 31;
            f32x4 st = (f32x4){0.f, 0.f, 0.f, 0.f};
#pragma unroll 8
            for (int c = 0; c < 64; ++c) { const size_t unit = (size_t)bh * 64 + c; const size_t o = (unit * 128 + v) * 128 + 4 * dg;
                *(unsigned long long*)(stT + o) = (unsigned long long)pk2(st[0], st[1]) | ((unsigned long long)pk2(st[2], st[3]) << 32);
                const f32x4 dc = *(const f32x4*)(decay + unit * 128 + 4 * dg); const unsigned long long kv = *(const unsigned long long*)(kvT + o);
                const unsigned klo = (unsigned)kv, khi = (unsigned)(kv >> 32);
                st[0] = dc[0] * st[0] + bflo(klo); st[1] = dc[1] * st[1] + bfhi(klo); st[2] = dc[2] * st[2] + bflo(khi); st[3] = dc[3] * st[3] + bfhi(khi); }
        }
    }
    SEAM(3);

    if (IN(4)) {
        constexpr int PB = 272;
        LAS char* qd = (LAS char*)(lds);
        LAS char* kd = (LAS char*)(lds + 17408);
        LAS char* vI = (LAS char*)(lds + 34816);
        LAS float* tot = (LAS float*)(lds + 52224);
        LAS float* ssx = (LAS float*)(lds + 56320);
        const int dp = tid & 63, seg = tid >> 6, r32 = lane & 31, hh = lane >> 5;
        const int troff = ((lane & 15) >> 2) * PB + (16 * ((lane >> 4) & 1) + 4 * (lane & 3)) * 2;
        const int vt = wave & 3, tt = wave >> 2;
        const int d0 = 2 * dp;
        unsigned qreg[8], zreg[8], vreg[8];
        f32x4 onv[4];
#pragma unroll
        for (int g = 0; g < 4; ++g) onv[g] = *(const f32x4*)(hgrn_onorm + 32 * vt + 4 * hh + 8 * g);
#define HG4_LOAD(unit_) do { const int b_ = (unit_) >> 9, h_ = ((unit_) >> 6) & 7, c_ = (unit_) & 63; const bf16* rp_ = qzvg + ((size_t)b_ * SEQ + c_ * 64 + 8 * seg) * 4096 + h_ * 128 + d0; \
            _Pragma("unroll") for (int i = 0; i < 8; ++i) { qreg[i] = *(const unsigned*)(rp_ + (size_t)i * 4096); zreg[i] = *(const unsigned*)(rp_ + (size_t)i * 4096 + 1024); vreg[i] = *(const unsigned*)(rp_ + (size_t)i * 4096 + 2048); } } while (0)
        if (bid < 2048) HG4_LOAD(bid);
        for (int unit = bid; unit < 2048; unit += G) {
            const int b = unit >> 9, h = (unit >> 6) & 7, c = unit & 63; const size_t r0 = (size_t)b * SEQ + c * 64;
            bf16x8 sa[8]; unsigned long long gg[4];
            { const bf16* sp = stT + ((size_t)unit * 128 + 32 * vt + r32) * 128 + 8 * hh;
#pragma unroll
              for (int ks = 0; ks < 8; ++ks) sa[ks] = *(const bf16x8*)(sp + 16 * ks);
              const bf16* gp = qzvg + (r0 + 32 * tt + r32) * 4096 + 3072 + h * 128 + 32 * vt + 4 * hh;
#pragma unroll
              for (int g = 0; g < 4; ++g) gg[g] = *(const unsigned long long*)(gp + 8 * g); }
            const float lb0 = lbv[h * 128 + d0], lb1 = lbv[h * 128 + d0 + 1];
            float bl0[8], bl1[8], k0[8], k1[8], q0[8], q1[8]; float run0 = 1.f, run1 = 1.f;
#pragma unroll
            for (int i = 0; i < 8; ++i) { const int t = 8 * seg + i; const unsigned qq = qreg[i], zz = zreg[i];
                const float e0 = __expf(-bflo(zz)), e1 = __expf(-bfhi(zz)), ri0 = __builtin_amdgcn_rcpf(1.f + e0), ri1 = __builtin_amdgcn_rcpf(1.f + e1);
                const float f0 = (1.f + lb0 * e0) * ri0, f1 = (1.f + lb1 * e1) * ri1;
                run0 *= f0; run1 *= f1; bl0[i] = run0; bl1[i] = run1; k0[i] = (1.f - lb0) * e0 * ri0; k1[i] = (1.f - lb1) * e1 * ri1; q0[i] = bflo(qq); q1[i] = bfhi(qq);
                *(LAS unsigned*)(vI + t * PB + d0 * 2) = vreg[i]; }
            if (unit + G < 2048) HG4_LOAD(unit + G);
            tot[seg * 128 + d0] = run0; tot[seg * 128 + d0 + 1] = run1;
            __syncthreads();
            float pre0 = 1.f, pre1 = 1.f;
#pragma unroll
            for (int s = 0; s < 8; ++s) { if (s < seg) { pre0 *= tot[s * 128 + d0]; pre1 *= tot[s * 128 + d0 + 1]; } }
#pragma unroll
            for (int i = 0; i < 8; ++i) { const int t = 8 * seg + i;
                const float x0 = pre0 * bl0[i], x1 = pre1 * bl1[i];
                *(LAS unsigned*)(qd + t * PB + d0 * 2) = cvtpk(q0[i] * x0, q1[i] * x1);
                *(LAS unsigned*)(kd + t * PB + d0 * 2) = cvtpk(k0[i] * __builtin_amdgcn_rcpf(x0), k1[i] * __builtin_amdgcn_rcpf(x1)); }
            __syncthreads();
            f32x16 O;
            {
                bf16x8 qf[8];
#pragma unroll
                for (int ks = 0; ks < 8; ++ks) qf[ks] = *(const LAS bf16x8*)(qd + (32 * tt + r32) * PB + (16 * ks + 8 * hh) * 2);
#pragma unroll
                for (int i = 0; i < 16; ++i) O[i] = 0.f;
#pragma unroll
                for (int ks = 0; ks < 8; ++ks) O = MFMA32(sa[ks], qf[ks], O);
#pragma unroll
                for (int st = 0; st < 2; ++st) {
                    if (st <= tt) {
                        f32x16 ST;
#pragma unroll
                        for (int i = 0; i < 16; ++i) ST[i] = 0.f;
#pragma unroll
                        for (int ks = 0; ks < 8; ++ks) { const bf16x8 ka = *(const LAS bf16x8*)(kd + (32 * st + r32) * PB + (16 * ks + 8 * hh) * 2); ST = MFMA32(ka, qf[ks], ST); }
                        if (st == tt) {
#pragma unroll
                            for (int i = 0; i < 16; ++i) ST[i] = (crow(i, hh) <= r32) ? ST[i] : 0.f; }
#pragma unroll
                        for (int s2 = 0; s2 < 2; ++s2) { const bf16x8 pb = PACK8(ST, s2);
                            const LAS char* rb = vI + (32 * st + 16 * s2 + 4 * hh) * PB + 64 * vt + troff;
                            const bf16x8 va = trpair(rb, rb + 8 * PB);
                            O = MFMA32(va, pb, O); }
                    }
                }
                float ssq = 0.f;
#pragma unroll
                for (int i = 0; i < 16; ++i) ssq += O[i] * O[i];
                ssq += __shfl_xor(ssq, 32);
                if (hh == 0) ssx[vt * 64 + 32 * tt + r32] = ssq;
            }
            __syncthreads();
            {
                const int t = 32 * tt + r32;
                const float tsum = (ssx[t] + ssx[64 + t]) + (ssx[128 + t] + ssx[192 + t]);
                const float rn = __builtin_amdgcn_rsqf(tsum * (1.f / 128.f) + EPS);
                bf16* op = oh + (r0 + t) * 1024 + h * 128 + 32 * vt + 4 * hh;
#pragma unroll
                for (int g = 0; g < 4; ++g) { const unsigned long long g8 = gg[g]; const f32x4 on = onv[g];
                    const float g0 = bflo((unsigned)g8), g1 = bfhi((unsigned)g8), g2 = bflo((unsigned)(g8 >> 32)), g3 = bfhi((unsigned)(g8 >> 32));
                    const float y0 = O[4 * g] * rn * on[0] * (g0 * __builtin_amdgcn_rcpf(1.f + __expf(-g0))), y1 = O[4 * g + 1] * rn * on[1] * (g1 * __builtin_amdgcn_rcpf(1.f + __expf(-g1)));
                    const float y2 = O[4 * g + 2] * rn * on[2] * (g2 * __builtin_amdgcn_rcpf(1.f + __expf(-g2))), y3 = O[4 * g + 3] * rn * on[3] * (g3 * __builtin_amdgcn_rcpf(1.f + __expf(-g3)));
                    *(unsigned long long*)(op + 8 * g) = (unsigned long long)cvtpk(y0, y1) | ((unsigned long long)cvtpk(y2, y3) << 32); }
            }
            __syncthreads();
        }
#undef HG4_LOAD
    }
    SEAM(4);

    if (IN(5)) {
        pg8::Gemm g{oh, W_oh, T, 1024, 1024, 0, nullptr, 0}; pg8::StaticOrder S; S.init(T, 1024, G, bid);
        pg8::EpiResid<true, true, false, true, 2> E{hb, nullptr, PROBE_SKIP(5) ? (bf16*)(args.ws + WS_QZVG) : hb, PROBE_SKIP(5) ? (unsigned char*)(args.ws + WS_QZVG + 64 * MiB) : hbi8, PROBE_SKIP(5) ? (float*)(args.ws + WS_QZVG + 96 * MiB) : ss1, 1.0f};
        STAGGER1();
        pg8::gemm_phase<pg8::EpiResid<true, true, false, true, 2>, pg8::StaticOrder, true, true>(lds + RING_OFF, g, S, E);
    }
    SEAM(5);

    if (IN(6)) {
        pg8::Gemm g{(const bf16*)hbi8, (const bf16*)W_fgu8, T, 2 * FF, 512, 0, nullptr, 0}; pg8::StaticOrder S; S.init(T, 2 * FF, G, bid);
        RSTD_TABLE(S, ss1, true)
        pg8::EpiSwiglu<1, false, true> E{actf, FF, ss1, 22, 1.0f / (I8_SA * I8_SW), 1.0f, rsl, pml, PROBE_SKIP(6)};
        STAGGER();
        pg8::gemm_phase<pg8::EpiSwiglu<1, false, true>, pg8::StaticOrder, true, true, 2>(lds + RING_OFF, g, S, E);
    }
    SEAM(6);

    if (IN(7)) {
        pg8::Gemm g{actf, W_fd, T, 1024, FF, 0, nullptr, 0}; pg8::StaticOrder S; S.init(T, 1024, G, bid);
        pg8::EpiResid<true, true, false, true, 1> E{hb, nullptr, PROBE_SKIP(7) ? (bf16*)(args.ws + WS_KVT) : hb, PROBE_SKIP(7) ? (unsigned char*)(args.ws + WS_KVT + 32 * MiB) : hb8, PROBE_SKIP(7) ? (float*)(args.ws + WS_KVT + 48 * MiB) : ss2, 1.0f};
        STAGGER1();
        pg8::gemm_phase<pg8::EpiResid<true, true, false, true, 1>, pg8::StaticOrder, true, true>(lds + RING_OFF, g, S, E);
    }
    SEAM(7);

    if (IN(8)) {
        pg8::Gemm g{(const bf16*)hb8, (const bf16*)W_kvq8, T, NKVQ, 512, 0, nullptr, 0}; pg8::StaticOrder S; S.init(T, NKVQ, G, bid);
        RSTD_TABLE(S, ss2, true)
        pg8::EpiScale<1, false> E{kvq, NKVQ, ss2, cosT, sinT, QSCALE, PROBE_SKIP(8), 1.0f / (FP8_SA * FP8_SW1), rsl, pml};
        STAGGER();
        pg8::gemm_phase<pg8::EpiScale<1, false>, pg8::StaticOrder, MOE_ALIGN, F8_SP2, 1>(lds + RING_OFF, g, S, E);
    }
    SEAM(8);

    if (IN(9)) {
        LAS char* Kimg = (LAS char*)(lds);
        LAS char* Vimg = (LAS char*)(lds + 49152);
        const int r32 = lane & 31, hh = lane >> 5, q4 = (lane & 15) >> 2, p4 = lane & 3, blk = (lane >> 4) & 1;
        float* lse = (float*)(args.ws + WS_LSE);
        const int gper = (3072 + G - 1) / G; const int gend = (bid + 1) * gper < 3072 ? (bid + 1) * gper : 3072;
        v4u pre[6];
#define ATT_CV(w, lo, hi) do { const f32x2_t a_ = __builtin_amdgcn_cvt_pk_f32_fp8((int)(w), false), b_ = __builtin_amdgcn_cvt_pk_f32_fp8((int)(w), true); lo = cvtpk(a_[0], a_[1]); hi = cvtpk(b_[0], b_[1]); } while (0)
#define ATT_DECODE(grp_) const int task0_ = (grp_) * 8; const int br = task0_ >> 13, rem_ = task0_ & 8191, bh = rem_ >> 7, sub_ = rem_ & 127; \
        const int dil = br == 0 ? 1 : (br == 1 ? 4 : 16), nq = 128 / dil, r = sub_ / nq, qt0 = sub_ - r * nq; const int Lsub = SEQ / dil; \
        const unsigned char* kbase = kvq8 + (size_t)br * T * 1024 + ((size_t)bh * 4096 + (size_t)r * Lsub) * 64; const unsigned char* vbase = kbase + (size_t)3 * T * 1024;
#define ATT_LOAD(grp_) do { ATT_DECODE(grp_) _Pragma("unroll") for (int c = 0; c < 6; ++c) { const int idx = tid + 512 * c; const int row = (c < 3 ? idx : idx - 1536) >> 2, qc = idx & 3; \
            int lk = 32 * qt0 - 128 + row; lk = lk < 0 ? 0 : lk; pre[c] = *(const v4u*)((c < 3 ? kbase : vbase) + (size_t)lk * 64 + 16 * qc); } } while (0)
        if (bid * gper < gend) ATT_LOAD(bid * gper);
        for (int grp = bid * gper; grp < gend; ++grp) {
            __syncthreads();
#pragma unroll
            for (int c = 0; c < 6; ++c) { const int idx = tid + 512 * c; const int row = (c < 3 ? idx : idx - 1536) >> 2, qc = idx & 3;
                v4u lo, hi; ATT_CV(pre[c].x, lo.x, lo.y); ATT_CV(pre[c].y, lo.z, lo.w); ATT_CV(pre[c].z, hi.x, hi.y); ATT_CV(pre[c].w, hi.z, hi.w);
                LAS char* img = (c < 3 ? Kimg : Vimg) + row * 128;
                *(LAS v4u*)(img + (((2 * qc) ^ (row & 7)) << 4)) = lo; *(LAS v4u*)(img + (((2 * qc + 1) ^ (row & 7)) << 4)) = hi; }
            __syncthreads();
            if (grp + 1 < gend) ATT_LOAD(grp + 1);
            ATT_DECODE(grp)
            const int b = bh >> 4, h = bh & 15, qt = qt0 + wave;
            const size_t tok0 = (size_t)b * SEQ + r;
            const size_t tokq = tok0 + (size_t)dil * (32 * qt + r32);
            const unsigned char* qp = kbase + (size_t)6 * T * 1024 + (size_t)(32 * qt + r32) * 64 + 8 * hh;
            bf16x8 qf[4];
#pragma unroll
            for (int s4 = 0; s4 < 4; ++s4) { const unsigned long long q8 = *(const unsigned long long*)(qp + 16 * s4);
                const f32x2_t a0 = __builtin_amdgcn_cvt_pk_f32_fp8((int)(unsigned)q8, false), a1 = __builtin_amdgcn_cvt_pk_f32_fp8((int)(unsigned)q8, true);
                const f32x2_t a2 = __builtin_amdgcn_cvt_pk_f32_fp8((int)(unsigned)(q8 >> 32), false), a3 = __builtin_amdgcn_cvt_pk_f32_fp8((int)(unsigned)(q8 >> 32), true);
                const float qs = 1.0f / 1024.0f;
                qf[s4] = __builtin_bit_cast(bf16x8, (v4u){cvtpk(a0[0] * qs, a0[1] * qs), cvtpk(a1[0] * qs, a1[1] * qs), cvtpk(a2[0] * qs, a2[1] * qs), cvtpk(a3[0] * qs, a3[1] * qs)}); }
            f32x16 S[5];
#pragma unroll
            for (int j = 0; j < 5; ++j) {
                const int row = 32 * (wave + j) + r32; const LAS char* kr = Kimg + row * 128;
#pragma unroll
                for (int i = 0; i < 16; ++i) S[j][i] = 0.f;
#pragma unroll
                for (int s4 = 0; s4 < 4; ++s4) { const bf16x8 kf = *(const LAS bf16x8*)(kr + (((2 * s4 + hh) ^ (row & 7)) << 4)); S[j] = MFMA32(kf, qf[s4], S[j]); }
            }
#pragma unroll
            for (int i = 0; i < 16; ++i) { const int key = crow(i, hh); S[0][i] = (key >= r32) ? S[0][i] : -INFINITY; S[4][i] = (key <= r32) ? S[4][i] : -INFINITY; }
            if (qt < 4) {
#pragma unroll
                for (int j = 0; j < 4; ++j)
#pragma unroll
                    for (int i = 0; i < 16; ++i) S[j][i] = (32 * qt - 128 + 32 * j + crow(i, hh) >= 0) ? S[j][i] : -INFINITY; }
            float mx = -INFINITY;
#pragma unroll
            for (int j = 0; j < 5; ++j)
#pragma unroll
                for (int i = 0; i < 16; ++i) mx = fmaxf(mx, S[j][i]);
            mx = fmaxf(mx, __shfl_xor(mx, 32));
            float ls = 0.f;
#pragma unroll
            for (int j = 0; j < 5; ++j)
#pragma unroll
                for (int i = 0; i < 16; ++i) { const float pz = __builtin_amdgcn_exp2f(S[j][i] - mx); S[j][i] = pz; ls += pz; }
            ls += __shfl_xor(ls, 32);
            f32x16 O0, O1;
#pragma unroll
            for (int i = 0; i < 16; ++i) { O0[i] = 0.f; O1[i] = 0.f; }
#pragma unroll
            for (int j = 0; j < 5; ++j) {
#pragma unroll
                for (int s2 = 0; s2 < 2; ++s2) { const bf16x8 pb = PACK8(S[j], s2);
                    const int R = 32 * (wave + j) + 16 * s2 + 4 * hh + q4;
                    const LAS char* rb = Vimg + R * 128 + 8 * (p4 & 1); const int sw = R & 7, c0 = 2 * blk + (p4 >> 1);
                    const bf16x8 va0 = trpair(rb + ((c0 ^ sw) << 4), rb + 8 * 128 + ((c0 ^ sw) << 4)), va1 = trpair(rb + (((4 + c0) ^ sw) << 4), rb + 8 * 128 + (((4 + c0) ^ sw) << 4));
                    O0 = MFMA32(va0, pb, O0); O1 = MFMA32(va1, pb, O1); }
            }
            const float inv = 1.0f / (16.0f * ls);
            bf16* op = oa + (size_t)br * T * 1024 + tokq * 1024 + h * 64 + 4 * hh;
#pragma unroll
            for (int g = 0; g < 4; ++g) {
                *(unsigned long long*)(op + 8 * g) = (unsigned long long)cvtpk(O0[4 * g] * inv, O0[4 * g + 1] * inv) | ((unsigned long long)cvtpk(O0[4 * g + 2] * inv, O0[4 * g + 3] * inv) << 32);
                *(unsigned long long*)(op + 32 + 8 * g) = (unsigned long long)cvtpk(O1[4 * g] * inv, O1[4 * g + 1] * inv) | ((unsigned long long)cvtpk(O1[4 * g + 2] * inv, O1[4 * g + 3] * inv) << 32); }
            if (hh == 0) lse[(size_t)br * T * 16 + tokq * 16 + h] = mx + __log2f(ls);
        }
#undef ATT_DECODE
#undef ATT_LOAD
#undef ATT_CV
    }
    SEAM(9);

    if (IN(10)) {
        const float* lse = (const float*)(args.ws + WS_LSE);
        for (int t = gw; t < T; t += NGW) {
            const int head = lane >> 2;
            const float l0 = lse[(size_t)t * 16 + head], l1 = lse[(size_t)T * 16 + (size_t)t * 16 + head], l2 = lse[(size_t)2 * T * 16 + (size_t)t * 16 + head];
            const float mm = fmaxf(l0, fmaxf(l1, l2));
            float w0 = __builtin_amdgcn_exp2f(l0 - mm), w1 = __builtin_amdgcn_exp2f(l1 - mm), w2 = __builtin_amdgcn_exp2f(l2 - mm);
            const float inv = 1.0f / (w0 + w1 + w2); w0 *= inv; w1 *= inv; w2 *= inv;
            bf16* p0 = oa + (size_t)t * 1024 + 16 * lane;
#pragma unroll
            for (int hf2 = 0; hf2 < 2; ++hf2) {
                const v4u a = *(const v4u*)(p0 + 8 * hf2), bq = *(const v4u*)(p0 + (size_t)T * 1024 + 8 * hf2), cq = *(const v4u*)(p0 + (size_t)2 * T * 1024 + 8 * hf2);
                const float s64 = 64.0f;
                const unsigned lo = pg8::pk4_fp8((w0 * bflo(a.x) + w1 * bflo(bq.x) + w2 * bflo(cq.x)) * s64, (w0 * bfhi(a.x) + w1 * bfhi(bq.x) + w2 * bfhi(cq.x)) * s64,
                                                 (w0 * bflo(a.y) + w1 * bflo(bq.y) + w2 * bflo(cq.y)) * s64, (w0 * bfhi(a.y) + w1 * bfhi(bq.y) + w2 * bfhi(cq.y)) * s64);
                const unsigned hi = pg8::pk4_fp8((w0 * bflo(a.z) + w1 * bflo(bq.z) + w2 * bflo(cq.z)) * s64, (w0 * bfhi(a.z) + w1 * bfhi(bq.z) + w2 * bfhi(cq.z)) * s64,
                                                 (w0 * bflo(a.w) + w1 * bflo(bq.w) + w2 * bflo(cq.w)) * s64, (w0 * bfhi(a.w) + w1 * bfhi(bq.w) + w2 * bfhi(cq.w)) * s64);
                *(unsigned long long*)(oa8 + (size_t)t * 1024 + 16 * lane + 8 * hf2) = (unsigned long long)lo | ((unsigned long long)hi << 32); }
        }
    }
    SEAM(10);

    if (IN(11)) {
        pg8::Gemm g{(const bf16*)oa8, (const bf16*)W_od8, T, 1024, 512, 0, nullptr, 0}; pg8::StaticOrder S; S.init(T, 1024, G, bid);
        pg8::EpiResid<false, true, false, true, 0> E{hb, nullptr, PROBE_SKIP(11) ? (bf16*)(args.ws + WS_KVQ) : hb, nullptr, nullptr, 1.0f / (64.0f * FP8_SW1)};
        STAGGER1();
        pg8::gemm_phase<pg8::EpiResid<false, true, false, true, 0>, pg8::StaticOrder, true, true, 1>(lds + RING_OFF, g, S, E);
    }
    SEAM(11);

    if (IN(12)) {
        const float* gain = ffn_norm + 1024;
#if defined(PROBE_K)
        if (!(args.li == 1 && lo == 12))
#endif
        for (int t = gw; t < T; t += NGW) {
            const v4u ha = *((const v4u*)(hb + (size_t)t * D) + 2 * lane), hc = *((const v4u*)(hb + (size_t)t * D) + 2 * lane + 1);
            float hv[16];
            hv[0] = bflo(ha.x); hv[1] = bfhi(ha.x); hv[2] = bflo(ha.y); hv[3] = bfhi(ha.y); hv[4] = bflo(ha.z); hv[5] = bfhi(ha.z); hv[6] = bflo(ha.w); hv[7] = bfhi(ha.w);
            hv[8] = bflo(hc.x); hv[9] = bfhi(hc.x); hv[10] = bflo(hc.y); hv[11] = bfhi(hc.y); hv[12] = bflo(hc.z); hv[13] = bfhi(hc.z); hv[14] = bflo(hc.w); hv[15] = bfhi(hc.w);
            float s = 0.f;
#pragma unroll
            for (int i = 0; i < 16; ++i) s += hv[i] * hv[i];
            s = wave_sum(s);
            const float rstd = __builtin_amdgcn_rsqf(s * (1.f / 1024.f) + EPS);
            float lg[8];
#pragma unroll
            for (int e = 0; e < 8; ++e) lg[e] = 0.f;
#pragma unroll
            for (int i = 0; i < 16; ++i) { const int k = 16 * lane + i; const float xv = hv[i] * gain[k];
                const f32x4 w0 = *(const f32x4*)(moe_wr + k * 8), w1 = *(const f32x4*)(moe_wr + k * 8 + 4);
                lg[0] += xv * w0[0]; lg[1] += xv * w0[1]; lg[2] += xv * w0[2]; lg[3] += xv * w0[3]; lg[4] += xv * w1[0]; lg[5] += xv * w1[1]; lg[6] += xv * w1[2]; lg[7] += xv * w1[3]; }
#pragma unroll
            for (int e = 0; e < 8; ++e) lg[e] = wave_sum(lg[e]) * rstd;
            int e1 = 0; float m1 = lg[0];
#pragma unroll
            for (int e = 1; e < 8; ++e) if (lg[e] > m1) { m1 = lg[e]; e1 = e; }
            int e2 = -1; float m2 = -INFINITY;
#pragma unroll
            for (int e = 0; e < 8; ++e) if (e != e1 && lg[e] > m2) { m2 = lg[e]; e2 = e; }
            const float p2 = __expf(m2 - m1); const float w1v = 1.f / (1.f + p2), w2v = p2 / (1.f + p2);
            if (lane == 0) { const unsigned pa = atomicAdd((unsigned*)(ctl + CW_CNT + 64 * e1), 1u), pb = atomicAdd((unsigned*)(ctl + CW_CNT + 64 * e2), 1u);
                tok_e[2 * t] = e1; tok_e[2 * t + 1] = e2; tok_p[2 * t] = (int)pa; tok_p[2 * t + 1] = (int)pb; tok_w[2 * t] = w1v; tok_w[2 * t + 1] = w2v; ss3[t] = s;
                rowtok[e1 * 16384 + (int)pa] = t; rowtok[e2 * 16384 + (int)pb] = t; }
            {
                const float rs = rstd * FP8_SA; v4u o;
                o.x = pg8::pk4_fp8(hv[0] * rs, hv[1] * rs, hv[2] * rs, hv[3] * rs); o.y = pg8::pk4_fp8(hv[4] * rs, hv[5] * rs, hv[6] * rs, hv[7] * rs);
                o.z = pg8::pk4_fp8(hv[8] * rs, hv[9] * rs, hv[10] * rs, hv[11] * rs); o.w = pg8::pk4_fp8(hv[12] * rs, hv[13] * rs, hv[14] * rs, hv[15] * rs);
                *((v4u*)(a8tok + (size_t)t * D) + lane) = o; }
        }
        LAS float* scr = (LAS float*)(lds + RING_OFF + wave * 16384);
        constexpr int I_G = 16 * 112, I_D = 56 * 32, I_E = 2 * I_G + I_D;
        for (int it = gw; it < NE * I_E; it += NGW) {
            const int e = it / I_E; int r = it - e * I_E;
            if (r < I_G) { transpose_item8(moe_wg + (size_t)e * 1024 * FFE, FFE, 1024, gain, FP8_SW1, W_gu + (size_t)e * 7168 * 1024, 1, 0, scr, r / 112, r % 112, lane); continue; } r -= I_G;
            if (r < I_G) { transpose_item8(moe_wu + (size_t)e * 1024 * FFE, FFE, 1024, gain, FP8_SW1, W_gu + (size_t)e * 7168 * 1024, 1, 128, scr, r / 112, r % 112, lane); continue; } r -= I_G;
            transpose_item8(moe_wd + (size_t)e * FFE * 1024, 1024, FFE, nullptr, FP8_SW2, W_d + (size_t)e * 1024 * FFE, 0, 0, scr, r / 32, r % 32, lane);
        }
    }
    SEAM(12);

    int tp1 = 0, tp2 = 0, tp3 = 0, tp4 = 0, tp5 = 0, tp6 = 0, tp7 = 0, tp8 = 0;
    if (hi > 13 && lo <= 15) {
        int c[8];
#pragma unroll
        for (int e = 0; e < 8; ++e) c[e] = (int)((__hip_atomic_load(ctl + CW_CNT + 64 * e, RLX_AGENT) + 255u) >> 8);
        tp1 = c[0]; tp2 = tp1 + c[1]; tp3 = tp2 + c[2]; tp4 = tp3 + c[3]; tp5 = tp4 + c[4]; tp6 = tp5 + c[5]; tp7 = tp6 + c[6]; tp8 = tp7 + c[7];
    }


    if (IN(14)) {
        for (int t = bid * NTHR + tid; t < 2 * T; t += G * NTHR) { const int e = tok_e[t];
            const int tb = e == 0 ? 0 : e == 1 ? tp1 : e == 2 ? tp2 : e == 3 ? tp3 : e == 4 ? tp4 : e == 5 ? tp5 : e == 6 ? tp6 : tp7;
            const int dst = tb * 256 + tok_p[t]; w_sorted[dst] = tok_w[t]; tok_d[t] = dst; }
        pg8::Gemm g{(const bf16*)a8tok, (const bf16*)W_gu, tp8 * 256, 7168, 512, 0, rowtok, T - 1};
        pg8::MoeOrder S{tp8, 28, tp8 * 28, G, bid, tp1, tp2, tp3, tp4, tp5, tp6, tp7};
        pg8::EpiSwiglu<2, true, false> E{actm, FFE, nullptr, 28, 1.0f / (FP8_SA * FP8_SW1), FP8_SACT, 0u, 0, PROBE_SKIP(14)};
        STAGGER();
        pg8::gemm_phase<pg8::EpiSwiglu<2, true, false>, pg8::MoeOrder, MOE_ALIGN, F8_SP2, 1, true>(lds + RING_OFF, g, S, E);
    }
    SEAM(14);

    if (IN(15)) {
        const int nmain = tp8 < 128 ? tp8 : 128;
        { pg8::Gemm g{(const bf16*)actm, (const bf16*)W_d, nmain * 256, 1024, FFE / 2, 0, nullptr, 0};
          pg8::MoeOrder S{nmain, 4, nmain * 4, G, bid, tp1, tp2, tp3, tp4, tp5, tp6, tp7};
          pg8::EpiDownMoe E{ymoe, w_sorted, 1.0f / (FP8_SACT * FP8_SW2)};
          pg8::gemm_phase<pg8::EpiDownMoe, pg8::MoeOrder, true, F8_SP2, 1>(lds + RING_OFF, g, S, E); }
        if (tp8 > 128) {
            __syncthreads();
            pg8::Gemm g{(const bf16*)actm, (const bf16*)W_d, tp8 * 256, 1024, FFE / 2, 4, nullptr, 0};
            pg8::LeftOrder S{128, (tp8 - 128) * 4 * 7, G, bid, 7, tp1, tp2, tp3, tp4, tp5, tp6, tp7};
            pg8::EpiDownPart E{ypart, w_sorted, 1.0f / (FP8_SACT * FP8_SW2), 32768, PART_ROWS};
            pg8::gemm_phase<pg8::EpiDownPart, pg8::LeftOrder, true, true, 1>(lds + RING_OFF, g, S, E);
        }
    }
    SEAM(15);

    if (IN(16)) {
        for (int t = gw; t < T; t += NGW) {
            const int d0 = tok_d[2 * t], d1 = tok_d[2 * t + 1];
            GAS f32x4* hr = (GAS f32x4*)(hf + (size_t)t * D) + lane;
            const GAS unsigned long long* h8p = (const GAS unsigned long long*)(hb + (size_t)t * D) + lane;
            f32x4 v[4]; float s = 0.f;
#pragma unroll
            for (int j = 0; j < 4; ++j) { const unsigned long long hq = h8p[64 * j];
                v[j] = (f32x4){bflo((unsigned)hq), bfhi((unsigned)hq), bflo((unsigned)(hq >> 32)), bfhi((unsigned)(hq >> 32))}; }
#pragma unroll
            for (int k2 = 0; k2 < 2; ++k2) { const int dd = k2 ? d1 : d0;
                if (dd < 32768) { const GAS unsigned long long* yp = (const GAS unsigned long long*)(ymoe + (size_t)dd * D) + lane;
#pragma unroll
                    for (int j = 0; j < 4; ++j) { const unsigned long long a = yp[64 * j]; v[j].x += bflo((unsigned)a); v[j].y += bfhi((unsigned)a); v[j].z += bflo((unsigned)(a >> 32)); v[j].w += bfhi((unsigned)(a >> 32)); } }
                else {
                    f32x4 ys[4];
#pragma unroll
                    for (int j = 0; j < 4; ++j) ys[j] = (f32x4){0.f, 0.f, 0.f, 0.f};
                    for (int ks = 0; ks < 7; ++ks) { const GAS unsigned long long* yp = (const GAS unsigned long long*)(ypart + ((size_t)ks * PART_ROWS + (dd - 32768)) * D) + lane;
#pragma unroll
                        for (int j = 0; j < 4; ++j) { const unsigned long long a = yp[64 * j]; ys[j].x += bflo((unsigned)a); ys[j].y += bfhi((unsigned)a); ys[j].z += bflo((unsigned)(a >> 32)); ys[j].w += bfhi((unsigned)(a >> 32)); } }
#pragma unroll
                    for (int j = 0; j < 4; ++j) v[j] = v[j] + ys[j]; } }
#pragma unroll
            for (int j = 0; j < 4; ++j) s += (v[j].x * v[j].x + v[j].y * v[j].y) + (v[j].z * v[j].z + v[j].w * v[j].w);
            s = wave_sum(s);
            const float rstd = __builtin_amdgcn_rsqf(s * (1.f / 1024.f) + EPS);
#pragma unroll
            for (int j = 0; j < 4; ++j) { const f32x4 gn = *((const GAS f32x4*)final_norm + lane + 64 * j); hr[64 * j] = v[j] * rstd * gn; }
        }
    }
#undef IN
#undef SEAM
#undef xin
#undef attn_norm
#undef ffn_norm
#undef hgrn_w_in
#undef hgrn_lb
#undef hgrn_onorm
#undef hgrn_w_out
#undef kv_norm
#undef w_kv
#undef dil_w_q
#undef dil_w_out
#undef ffn_wg
#undef ffn_wu
#undef ffn_wd
#undef moe_wr
#undef moe_wg
#undef moe_wu
#undef moe_wd
#undef final_norm
#undef hf
#undef hb
#undef hb8
#undef a8tok
#undef rowtok
#undef ypart
#undef W_od8
#undef oa8
#undef W_in8
#undef xq8
#undef hbi8
#undef W_kvq8
#undef W_fgu8
#undef W_fd8
#undef actf8
#undef cosT
#undef sinT
#undef lbv
#undef ss0
#undef ss1
#undef ss2
#undef ss3
#undef W_in
#undef W_oh
#undef W_fgu
#undef W_fd
#undef W_kvq
#undef W_od
#undef W_gu
#undef W_d
#undef qzvg
#undef kvT
#undef stT
#undef oh
#undef actf
#undef kvq
#undef kvq8
#undef oa
#undef asort
#undef actm
#undef ymoe
#undef decay
#undef tok_e
#undef tok_p
#undef tok_w
#undef tok_d
#undef ss_sorted
#undef w_sorted
#undef ctl
}

#ifndef MK_N_LAUNCHES
#define MK_N_LAUNCHES 1
#endif
extern "C" void kernel_launch(void* const* d_in, const int* in_sizes, int n_in, void* d_out, int out_size, void* d_ws, size_t ws_size, hipStream_t stream) {
    static int grid = 0;
    if (grid == 0) {
        if (n_in != 19 || in_sizes[0] != T * D || out_size != T * D || ws_size < WS_END) { fprintf(stderr, "kernel_launch: unexpected shapes / workspace (n_in %d, ws %zu); nothing launched\n", n_in, ws_size); grid = -1; return; }
        int dev = 0, cus = 0, per_cu = 0;
        if (hipGetDevice(&dev) != hipSuccess || hipDeviceGetAttribute(&cus, hipDeviceAttributeMultiprocessorCount, dev) != hipSuccess) { grid = -1; return; }
        if (hipFuncSetAttribute((const void*)fwd_kernel, hipFuncAttributeMaxDynamicSharedMemorySize, LDS_BYTES) != hipSuccess) { fprintf(stderr, "kernel_launch: hipFuncSetAttribute failed\n"); grid = -1; return; }
        if (hipOccupancyMaxActiveBlocksPerMultiprocessor(&per_cu, (const void*)fwd_kernel, NTHR, LDS_BYTES) != hipSuccess || per_cu < 1) { fprintf(stderr, "kernel_launch: occupancy query reports %d\n", per_cu); }
        (void)hipGetLastError();
        grid = cus;
        if (grid != 256) { fprintf(stderr, "kernel_launch: built for a 256-CU device (got %d CUs); nothing launched\n", grid); grid = -1; return; }
    }
    if (grid < 0) return;
    if (hipMemsetAsync((char*)d_ws + WS_CTL, 0, CTL_ZERO_BYTES, stream) != hipSuccess) return;
    Args a{};
    for (int i = 0; i < 19; ++i) a.in[i] = (const float*)d_in[i];
    a.out = (float*)d_out; a.ws = (unsigned char*)d_ws;
#if defined(PROBE_K)
    a.ph_lo = 0; a.ph_hi = PROBE_K + 1; a.li = 0; hipLaunchKernelGGL(fwd_kernel, dim3(grid), dim3(NTHR), LDS_BYTES, stream, a);
    a.ph_lo = PROBE_K; a.ph_hi = NPHASE; a.li = 1; hipLaunchKernelGGL(fwd_kernel, dim3(grid), dim3(NTHR), LDS_BYTES, stream, a);
    return;
#endif
    if (MK_N_LAUNCHES == 1) { a.ph_lo = 0; a.ph_hi = NPHASE; hipLaunchKernelGGL(fwd_kernel, dim3(grid), dim3(NTHR), LDS_BYTES, stream, a); }
    else for (int p = 0; p < NPHASE; ++p) { a.ph_lo = p; a.ph_hi = p + 1; hipLaunchKernelGGL(fwd_kernel, dim3(grid), dim3(NTHR), LDS_BYTES, stream, a); }
}
```

```cpp
#include <hip/hip_runtime.h>
#include <cstdio>
#include <cstdint>
#include <cmath>
namespace pg8 {
#define PG8_LAS __attribute__((address_space(3)))
typedef unsigned short bf16_t;
typedef short bf16x8 __attribute__((ext_vector_type(8)));
typedef float f32x4 __attribute__((ext_vector_type(4)));
typedef unsigned u32x4 __attribute__((ext_vector_type(4)));
typedef int v4i_t __attribute__((ext_vector_type(4)));
typedef int v8i_t __attribute__((ext_vector_type(8)));
typedef float f32x2 __attribute__((ext_vector_type(2)));
constexpr int BM = 256, BK = 64, HALF = 128, HTB = HALF * BK * 2  , STAGE_BYTES = 8 * HTB, NXCD = 8, WGM = 8;

__host__ __device__ __forceinline__ int lds_byte(int r, int c) { const int st = (r >> 4) * 2 + (c >> 5), rr = r & 15, cc = c & 31, ob = rr * 64 + cc * 2; return st * 1024 + (ob ^ (((ob >> 9) & 1) << 5)); }
__host__ __device__ __forceinline__ void stage_rc(int b, int& R, int& C) { const int st = b / 1024, sb = b % 1024, swz = sb ^ (((sb >> 9) & 1) << 5); R = (st >> 1) * 16 + swz / 64; C = (st & 1) * 32 + (swz % 64) / 2; }
__host__ __device__ __forceinline__ int perm32(int rho) { const int n = rho >> 4, i = rho & 15; return 8 * (i >> 2) + 4 * n + (i & 3); }

struct Unit { int pm, pn, ks, lo; };
struct Gemm { const bf16_t* A; const bf16_t* Bt; int M, N, K; int nt; const int* rowlist; int rowmax; };

struct StaticOrder {
    int nM, nN, nwg, G, c;
    __host__ __device__ __forceinline__ void init(int M, int N, int G_, int c_) { nM = M / BM; nN = N / BM; nwg = nM * nN; G = G_; c = c_; }
    __host__ __device__ __forceinline__ bool next(int i, Unit& u) const {
        const long L = (long)i * G + c; if (L >= nwg) return false;
        int wgid = (int)L; { const int q = nwg / NXCD, r = nwg % NXCD, xcd = wgid % NXCD, off = wgid / NXCD; wgid = (xcd < r ? xcd * (q + 1) : r * (q + 1) + (xcd - r) * q) + off; }
        const int nig = WGM * nN, gid = wgid / nig, fm = gid * WGM, gsz = (nM - fm) < WGM ? (nM - fm) : WGM;
        u.pm = fm + ((wgid % nig) % gsz); u.pn = (wgid % nig) / gsz; u.ks = 0; u.lo = 0; return true;
    }
    __device__ __forceinline__ void a_ready(const Unit&) const {}
    __device__ __forceinline__ void done(const Unit&) const {}
};

__device__ __forceinline__ unsigned cvt_pk_bf16(float lo, float hi) { unsigned r; asm volatile("v_cvt_pk_bf16_f32 %0, %1, %2" : "=v"(r) : "v"(lo), "v"(hi)); return r; }

constexpr float RMS_EPS = 1e-6f;
template <bool SLOTS> __device__ __forceinline__ float row_ss(const float* ss, int row) {
    if (!SLOTS) return ss[row];
    const f32x4* p = (const f32x4*)(ss + (size_t)row * 16); const f32x4 a = p[0], b = p[1], c = p[2], d = p[3];
    return (((a[0] + a[1]) + (a[2] + a[3])) + ((b[0] + b[1]) + (b[2] + b[3]))) + (((c[0] + c[1]) + (c[2] + c[3])) + ((d[0] + d[1]) + (d[2] + d[3])));
}
#ifndef G1_NT
#define G1_NT 0
#endif
#ifndef WT_STORES
#define WT_STORES 0
#endif
__device__ __forceinline__ void st16(void* p, u32x4 v) { if (WT_STORES) asm volatile("global_store_dwordx4 %0, %1, off sc1\n\ts_nop 2" :: "v"(p), "v"(v) : "memory"); else *(u32x4*)p = v; }
__device__ __forceinline__ void st16f(void* p, f32x4 v) { if (WT_STORES) asm volatile("global_store_dwordx4 %0, %1, off sc1\n\ts_nop 2" :: "v"(p), "v"(v) : "memory"); else *(f32x4*)p = v; }
__device__ __forceinline__ void st8(void* p, unsigned long long v) { if (WT_STORES) asm volatile("global_store_dwordx2 %0, %1, off sc1\n\ts_nop 2" :: "v"(p), "v"(v) : "memory"); else *(unsigned long long*)p = v; }
__device__ __forceinline__ float row_rstd(unsigned rsl, int row) { return *(const PG8_LAS float*)(rsl + 4u * (unsigned)(row & 255)); }
#ifndef FP8_SOFT_ENCODE
#define FP8_SOFT_ENCODE 0
#endif
__device__ __forceinline__ unsigned enc_e4m3_soft(float x) {
    const unsigned u = __float_as_uint(x), a = u & 0x7fffffffu, sg = (u >> 24) & 0x80u; unsigned r;
    if (a >= 0x3c800000u) { r = (a + 0x7ffffu + ((a >> 20) & 1u)) >> 20; r -= (127u - 7u) << 3; r = r > 0x7eu ? 0x7eu : r; }
    else { r = (unsigned)__builtin_rintf(__uint_as_float(a) * 512.0f); }
    return r | sg;
}
__device__ __forceinline__ unsigned pk4_fp8(float a, float b, float c, float d) {
    a = __builtin_amdgcn_fmed3f(a, -448.f, 448.f); b = __builtin_amdgcn_fmed3f(b, -448.f, 448.f); c = __builtin_amdgcn_fmed3f(c, -448.f, 448.f); d = __builtin_amdgcn_fmed3f(d, -448.f, 448.f);
    if (FP8_SOFT_ENCODE) return enc_e4m3_soft(a) | (enc_e4m3_soft(b) << 8) | (enc_e4m3_soft(c) << 16) | (enc_e4m3_soft(d) << 24);
    unsigned w = __float_as_uint(a);
    w = (unsigned)__builtin_amdgcn_cvt_pk_fp8_f32(a, b, (int)w, false); w = (unsigned)__builtin_amdgcn_cvt_pk_fp8_f32(c, d, (int)w, true); return w;
}
template <int MODE, bool ACCI = false> struct EpiScale {
    static constexpr bool PERM = true, AFTER_DRAIN = false;
    bf16_t* O; int ldc; const float* ss; const float* cosT; const float* sinT; float qscale; int skip; float accscale; unsigned rsl; int pml;
    __device__ __forceinline__ void operator()(const f32x4 (&acc)[2][2][4][2], const Unit& u, int wr, int wc, int fr, int fq) const {
        if (skip == 2) return;
        const int row0 = u.pm * BM + wr * 64 + fr, col0 = u.pn * BM + wc * 32 + 8 * fq;
        const int kind3 = (MODE == 1) ? u.pn / 12 : 0;
        const int kind = (MODE == 1) ? (kind3 == 0 ? 1 : (kind3 == 1 ? 0 : 2)) : 0;
        const int j4 = ((4 * wc + fq) & 7) * 4;
        const int br = (u.pn % 12) >> 2, sh = 2 * br, hbase = 4 * (u.pn & 3) + (wc >> 1), doff = 32 * (wc & 1) + 8 * fq;
        if (MODE == 1) {
            const float osc = (kind == 2 ? qscale * 64.f : 16.f) * accscale;
#pragma unroll
            for (int ai = 0; ai < 2; ++ai)
#pragma unroll
                for (int m = 0; m < 4; ++m) { const int row = row0 + ai * HALF + m * 16;
                    const float s = row_rstd(rsl, row) * osc;
                    const int t = row & 4095, b = row >> 12;
                    f32x4 cs = (f32x4){s, s, s, s}, sn = (f32x4){0.f, 0.f, 0.f, 0.f};
                    if (kind) { cs = *(const f32x4*)(cosT + t * 32 + j4) * s; sn = *(const f32x4*)(sinT + t * 32 + j4) * s; }
                    const int pos = ((t & ((1 << sh) - 1)) << (12 - sh)) + (t >> sh);
                    unsigned char* rowp8 = (unsigned char*)O + (size_t)(kind3 * 3 + br) * ((size_t)16384 * 1024) + ((size_t)(b * 16 + hbase) * 4096 + pos) * 64 + doff;
#pragma unroll
                    for (int bj = 0; bj < 2; ++bj) { const f32x4 a0 = acc[ai][bj][m][0], a1 = acc[ai][bj][m][1];
                        const f32x4 r0 = a0 * cs - a1 * sn, r1 = a1 * cs + a0 * sn;
                        if (!skip) st8(rowp8 + bj * (2 * 4096 * 64), (unsigned long long)pk4_fp8(r0[0], r0[1], r0[2], r0[3]) | ((unsigned long long)pk4_fp8(r1[0], r1[1], r1[2], r1[3]) << 32)); } }
            return;
        }
#pragma unroll
        for (int ai = 0; ai < 2; ++ai)
#pragma unroll
            for (int m = 0; m < 4; ++m) { const int row = row0 + ai * HALF + m * 16;
                const float s = row_rstd(rsl, row) * accscale;
                bf16_t* rowp = O + (size_t)row * ldc + col0;
#pragma unroll
                for (int bj = 0; bj < 2; ++bj) { const f32x4 v0 = (ACCI ? __builtin_convertvector(__builtin_bit_cast(v4i_t, acc[ai][bj][m][0]), f32x4) : acc[ai][bj][m][0]) * s, v1 = (ACCI ? __builtin_convertvector(__builtin_bit_cast(v4i_t, acc[ai][bj][m][1]), f32x4) : acc[ai][bj][m][1]) * s;
                    u32x4 w; w.x = cvt_pk_bf16(v0[0], v0[1]); w.y = cvt_pk_bf16(v0[2], v0[3]); w.z = cvt_pk_bf16(v1[0], v1[1]); w.w = cvt_pk_bf16(v1[2], v1[3]);
                    if (!skip) { if (G1_NT) __builtin_nontemporal_store(w, (u32x4*)(rowp + bj * HALF)); else st16(rowp + bj * HALF, w); } } }
    }
};
__device__ __forceinline__ unsigned pk4_i8(float a, float b, float c, float d) {
    const int ia = (int)__builtin_rintf(__builtin_amdgcn_fmed3f(a, -127.f, 127.f)), ib = (int)__builtin_rintf(__builtin_amdgcn_fmed3f(b, -127.f, 127.f));
    const int ic = (int)__builtin_rintf(__builtin_amdgcn_fmed3f(c, -127.f, 127.f)), id = (int)__builtin_rintf(__builtin_amdgcn_fmed3f(d, -127.f, 127.f));
    return ((unsigned)ia & 0xffu) | (((unsigned)ib & 0xffu) << 8) | (((unsigned)ic & 0xffu) << 16) | ((unsigned)id << 24);
}
template <bool SS, bool RB16, bool F32, bool B16, int F8> struct EpiResid {
    static constexpr bool PERM = true, AFTER_DRAIN = false;
    const void* resid; float* hout; bf16_t* hb; unsigned char* h8; float* ssout; float accscale;
    __device__ __forceinline__ void operator()(const f32x4 (&acc)[2][2][4][2], const Unit& u, int wr, int wc, int fr, int fq) const {
        const int row0 = u.pm * BM + wr * 64 + fr, col0 = u.pn * BM + wc * 32 + 8 * fq;
#pragma unroll
        for (int ai = 0; ai < 2; ++ai)
#pragma unroll
            for (int m = 0; m < 4; ++m) { const int row = row0 + ai * HALF + m * 16; float part = 0.f;
#pragma unroll
                for (int bj = 0; bj < 2; ++bj) { const size_t off = (size_t)row * 1024 + col0 + bj * HALF;
                    f32x4 r0, r1;
                    if (RB16) { const u32x4 rr = *(const u32x4*)((const bf16_t*)resid + off);
                        r0 = (f32x4){__uint_as_float(rr.x << 16), __uint_as_float(rr.x & 0xffff0000u), __uint_as_float(rr.y << 16), __uint_as_float(rr.y & 0xffff0000u)};
                        r1 = (f32x4){__uint_as_float(rr.z << 16), __uint_as_float(rr.z & 0xffff0000u), __uint_as_float(rr.w << 16), __uint_as_float(rr.w & 0xffff0000u)}; }
                    else { r0 = *(const f32x4*)((const float*)resid + off); r1 = *(const f32x4*)((const float*)resid + off + 4); }
                    const f32x4 v0 = acc[ai][bj][m][0] * accscale + r0, v1 = acc[ai][bj][m][1] * accscale + r1;
                    if (F32) { st16f(hout + off, v0); st16f(hout + off + 4, v1); }
                    if (F8 == 1) { st8(h8 + off, (unsigned long long)pk4_fp8(v0[0] * 16.f, v0[1] * 16.f, v0[2] * 16.f, v0[3] * 16.f) | ((unsigned long long)pk4_fp8(v1[0] * 16.f, v1[1] * 16.f, v1[2] * 16.f, v1[3] * 16.f) << 32)); }
                    if (F8 == 2) { st8(h8 + off, (unsigned long long)pk4_i8(v0[0] * 21.0f, v0[1] * 21.0f, v0[2] * 21.0f, v0[3] * 21.0f) | ((unsigned long long)pk4_i8(v1[0] * 21.0f, v1[1] * 21.0f, v1[2] * 21.0f, v1[3] * 21.0f) << 32)); }
                    if (B16) { u32x4 w; w.x = cvt_pk_bf16(v0[0], v0[1]); w.y = cvt_pk_bf16(v0[2], v0[3]); w.z = cvt_pk_bf16(v1[0], v1[1]); w.w = cvt_pk_bf16(v1[2], v1[3]);
                        st16(hb + off, w); }
                    if (SS) part += (v0[0] * v0[0] + v0[1] * v0[1]) + (v0[2] * v0[2] + v0[3] * v0[3]) + (v1[0] * v1[0] + v1[1] * v1[1]) + (v1[2] * v1[2] + v1[3] * v1[3]); }
                if (SS) { part += __shfl_xor(part, 16); part += __shfl_xor(part, 32); if (fq == 0) ssout[(size_t)row * 16 + u.pn * 4 + wc] = part; } }
    }
};
template <int SSMODE, bool OUT8, bool ACCI = false> struct EpiSwiglu {
    static constexpr bool PERM = true, AFTER_DRAIN = false;
    void* O; int ldc; const float* ss; int nN; float inscale, outscale; unsigned rsl; int pml; int skip;
    __device__ __forceinline__ void operator()(const f32x4 (&acc)[2][2][4][2], const Unit& u, int wr, int wc, int fr, int fq) const {
        if (skip) return;
        const int pnl = u.pn % nN; const int row0 = u.pm * BM + wr * 64 + fr, col0 = pnl * HALF + wc * 32 + 8 * fq;
#pragma unroll
        for (int ai = 0; ai < 2; ++ai)
#pragma unroll
            for (int m = 0; m < 4; ++m) { const int row = row0 + ai * HALF + m * 16;
                float s = inscale; if (SSMODE != 2) s *= row_rstd(rsl, row);
                f32x4 o[2];
                const float c1 = -1.4426950408889634f * s, c2 = s * s * outscale;
#pragma unroll
                for (int n = 0; n < 2; ++n) { const f32x4 ga = ACCI ? __builtin_convertvector(__builtin_bit_cast(v4i_t, acc[ai][0][m][n]), f32x4) : acc[ai][0][m][n], ua = ACCI ? __builtin_convertvector(__builtin_bit_cast(v4i_t, acc[ai][1][m][n]), f32x4) : acc[ai][1][m][n];
#pragma unroll
                    for (int h2 = 0; h2 < 2; ++h2) { const f32x2 g2 = (f32x2){ga[2 * h2], ga[2 * h2 + 1]}, u2 = (f32x2){ua[2 * h2], ua[2 * h2 + 1]};
                        const f32x2 ex = g2 * c1, gu = g2 * u2; f32x2 e2; e2.x = __builtin_amdgcn_exp2f(ex.x); e2.y = __builtin_amdgcn_exp2f(ex.y);
                        const f32x2 d2 = e2 + 1.0f; f32x2 r2; r2.x = __builtin_amdgcn_rcpf(d2.x); r2.y = __builtin_amdgcn_rcpf(d2.y);
                        const f32x2 o2 = gu * (r2 * c2); o[n][2 * h2] = o2.x; o[n][2 * h2 + 1] = o2.y; } }
                if (OUT8) { st8((unsigned char*)O + (size_t)row * ldc + col0, (unsigned long long)pk4_fp8(o[0][0], o[0][1], o[0][2], o[0][3]) | ((unsigned long long)pk4_fp8(o[1][0], o[1][1], o[1][2], o[1][3]) << 32)); }
                else { u32x4 w; w.x = cvt_pk_bf16(o[0][0], o[0][1]); w.y = cvt_pk_bf16(o[0][2], o[0][3]); w.z = cvt_pk_bf16(o[1][0], o[1][1]); w.w = cvt_pk_bf16(o[1][2], o[1][3]);
                    st16((bf16_t*)O + (size_t)row * ldc + col0, w); } }
    }
};
struct EpiDownMoe {
    static constexpr bool PERM = true, AFTER_DRAIN = false;
    bf16_t* Y; const float* w; float cscale;
    __device__ __forceinline__ void operator()(const f32x4 (&acc)[2][2][4][2], const Unit& u, int wr, int wc, int fr, int fq) const {
        const int pnl = u.pn & 3; const int row0 = u.pm * BM + wr * 64 + fr, col0 = pnl * BM + wc * 32 + 8 * fq;
#pragma unroll
        for (int ai = 0; ai < 2; ++ai)
#pragma unroll
            for (int m = 0; m < 4; ++m) { const int row = row0 + ai * HALF + m * 16; const float s = w[row] * cscale;
                bf16_t* rowp = Y + (size_t)row * 1024 + col0;
#pragma unroll
                for (int bj = 0; bj < 2; ++bj) { const f32x4 v0 = acc[ai][bj][m][0] * s, v1 = acc[ai][bj][m][1] * s;
                    u32x4 w4; w4.x = cvt_pk_bf16(v0[0], v0[1]); w4.y = cvt_pk_bf16(v0[2], v0[3]); w4.z = cvt_pk_bf16(v1[0], v1[1]); w4.w = cvt_pk_bf16(v1[2], v1[3]);
                    st16(rowp + bj * HALF, w4); } }
    }
};
struct PanelOrder {
    int pm, p0, cnt;
    __device__ __forceinline__ bool next(int i, Unit& u) const { if (i >= cnt) return false; int pn = p0 + i; asm volatile("" : "+s"(pn));
        u.pm = pm; u.pn = pn; u.ks = 0; u.lo = 0; return true; }
    __device__ __forceinline__ void a_ready(const Unit&) const {}
    __device__ __forceinline__ void done(const Unit&) const {}
};
struct LeftOrder {
    int tile0, nleft, G, c, NS; int t1, t2, t3, t4, t5, t6, t7;
    __device__ __forceinline__ bool next(int i, Unit& u) const {
        const int L = i * G + c; if (L >= nleft) return false;
        const int ks = L % NS, rest = L / NS, pnl = rest & 3, pm = tile0 + (rest >> 2);
        const int e = (pm >= t1) + (pm >= t2) + (pm >= t3) + (pm >= t4) + (pm >= t5) + (pm >= t6) + (pm >= t7);
        u.pm = pm; u.pn = e * 4 + pnl; u.ks = ks; u.lo = 0; return true;
    }
    __device__ __forceinline__ void a_ready(const Unit&) const {}
    __device__ __forceinline__ void done(const Unit&) const {}
};
struct EpiDownPart {
    static constexpr bool PERM = true, AFTER_DRAIN = false;
    bf16_t* P; const float* w; float cscale; int row0, prows;
    __device__ __forceinline__ void operator()(const f32x4 (&acc)[2][2][4][2], const Unit& u, int wr, int wc, int fr, int fq) const {
        const int pnl = u.pn & 3; const int rowb = u.pm * BM + wr * 64 + fr, col0 = pnl * BM + wc * 32 + 8 * fq;
#pragma unroll
        for (int ai = 0; ai < 2; ++ai)
#pragma unroll
            for (int m = 0; m < 4; ++m) { const int row = rowb + ai * HALF + m * 16; const float s = w[row] * cscale;
                bf16_t* rowp = P + ((size_t)u.ks * prows + (row - row0)) * 1024 + col0;
#pragma unroll
                for (int bj = 0; bj < 2; ++bj) { const f32x4 v0 = acc[ai][bj][m][0] * s, v1 = acc[ai][bj][m][1] * s;
                    u32x4 w4; w4.x = cvt_pk_bf16(v0[0], v0[1]); w4.y = cvt_pk_bf16(v0[2], v0[3]); w4.z = cvt_pk_bf16(v1[0], v1[1]); w4.w = cvt_pk_bf16(v1[2], v1[3]);
                    st16(rowp + bj * HALF, w4); } }
    }
};
struct MoeOrder {
    int nM, nN, nwg, G, c; int t1, t2, t3, t4, t5, t6, t7;
    __device__ __forceinline__ bool next(int i, Unit& u) const {
        const long L = (long)i * G + c; if (L >= nwg) return false;
        int wgid = (int)L; { const int q = nwg / NXCD, r = nwg % NXCD, xcd = wgid % NXCD, off = wgid / NXCD; wgid = (xcd < r ? xcd * (q + 1) : r * (q + 1) + (xcd - r) * q) + off; }
        const int nig = WGM * nN, gid = wgid / nig, fm = gid * WGM, gsz = (nM - fm) < WGM ? (nM - fm) : WGM;
        const int pm = fm + ((wgid % nig) % gsz), pnl = (wgid % nig) / gsz;
        const int e = (pm >= t1) + (pm >= t2) + (pm >= t3) + (pm >= t4) + (pm >= t5) + (pm >= t6) + (pm >= t7);
        const int tb = e == 0 ? 0 : e == 1 ? t1 : e == 2 ? t2 : e == 3 ? t3 : e == 4 ? t4 : e == 5 ? t5 : e == 6 ? t6 : t7;
        u.pm = pm; u.pn = e * nN + pnl; u.ks = 0; u.lo = e * 16384 + (pm - tb) * 256; return true;
    }
    __device__ __forceinline__ void a_ready(const Unit&) const {}
    __device__ __forceinline__ void done(const Unit&) const {}
};
#ifndef FP8_DEBUG_NONSCALED
#define FP8_DEBUG_NONSCALED 0
#endif
template <class Epi, class Sched, bool ALIGN_EPI = false, bool SP2 = false, int FP8 = 0, bool AIND = false>
__device__ __forceinline__ void gemm_phase(PG8_LAS unsigned char* lds, const Gemm g, const Sched S, const Epi E) {
    const int tid = threadIdx.x, wid = __builtin_amdgcn_readfirstlane(tid >> 6), lane = tid & 63, wr = wid >> 2, wc = wid & 3, fr = lane & 15, fq = lane >> 4;
    const int K = g.K, nt = g.nt ? g.nt : K / BK;
    unsigned voffA[2], voffB[2];
#pragma unroll
    for (int i = 0; i < 2; ++i) { int R, C; stage_rc(tid * 16 + i * 8192, R, C); const int Rb = Epi::PERM ? ((R & ~31) + perm32(R & 31)) : R;
        voffA[i] = (unsigned)(R * K + C) * 2u; voffB[i] = (unsigned)(Rb * K + C) * 2u; }
    const size_t kstep = (size_t)(BK * 2);
    const size_t hstep = (size_t)HALF * K * 2;
    const size_t hstepA = AIND ? (size_t)0 : hstep;
    unsigned cvo[2][2];
#pragma unroll
    for (int h = 0; h < 2; ++h)
#pragma unroll
        for (int i = 0; i < 2; ++i) cvo[h][i] = voffA[i];
    PG8_LAS unsigned char* rtab = lds + STAGE_BYTES + 4096;
#define PG8_RT_FILL(slot, un) do { __builtin_amdgcn_global_load_lds((const unsigned*)(g.rowlist + (un).lo + (wid & 3) * 64 + lane), (PG8_LAS unsigned*)(rtab + (slot) * 1024 + (wid & 3) * 256), 4, 0, 0); } while (0)
#define PG8_RT_OFFS(slot) do { _Pragma("unroll") for (int h_ = 0; h_ < 2; ++h_) _Pragma("unroll") for (int i_ = 0; i_ < 2; ++i_) { int R_, C_; stage_rc(tid * 16 + i_ * 8192, R_, C_); \
        unsigned tk_ = *(const PG8_LAS unsigned*)(rtab + (slot) * 1024 + 4 * (128 * h_ + R_)); tk_ = tk_ < (unsigned)g.rowmax ? tk_ : (unsigned)g.rowmax; cvo[h_][i_] = tk_ * (unsigned)(K * 2) + (unsigned)C_ * 2u; } } while (0)
    const size_t tstep = 2 * hstep;
    const unsigned ldsw = (unsigned)wid * 1024u;
    const int aoff = lds_byte(wr * 64 + fr, fq * 8), boff = lds_byte(wc * 32 + fr, fq * 8);
#define PG8_SA(b, h) (((b) * 2 + (h)) * HTB)
#define PG8_SB(b, h) ((4 + (b) * 2 + (h)) * HTB)
#define PG8_STAGE(bufoff, gbase, voff) do { _Pragma("unroll") for (int _i = 0; _i < 2; ++_i) \
        __builtin_amdgcn_global_load_lds((const unsigned*)((const char*)(gbase) + (voff)[_i]), (PG8_LAS unsigned*)(lds + (bufoff) + ldsw + _i * 8192), 16, 0, 0); } while (0)
#define PG8_STAGE_A(bufoff, gbase, H) PG8_STAGE(bufoff, (gbase) + (H) * hstepA, cvo[H])
#define PG8_CAT(p0) __builtin_shufflevector(*(const PG8_LAS v4i_t*)(p0), *(const PG8_LAS v4i_t*)((p0) + 1024), 0, 1, 2, 3, 4, 5, 6, 7)
#define PG8_LO(x) __builtin_bit_cast(bf16x8, __builtin_shufflevector((x), (x), 0, 1, 2, 3))
#define PG8_HI(x) __builtin_bit_cast(bf16x8, __builtin_shufflevector((x), (x), 4, 5, 6, 7))
#define PG8_LDA(dst, b, h) do { _Pragma("unroll") for (int m = 0; m < 4; ++m) dst[m] = PG8_CAT(lds + PG8_SA(b, h) + aoff + m * 2048); } while (0)
#define PG8_LDB(dst, b, h) do { _Pragma("unroll") for (int n = 0; n < 2; ++n) dst[n] = PG8_CAT(lds + PG8_SB(b, h) + boff + n * 2048); } while (0)
#define PG8_MMA(ai, bj, At, Bt) do { __builtin_amdgcn_s_setprio(1); \
        if constexpr (FP8 == 2) { _Pragma("unroll") for (int m = 0; m < 4; ++m) _Pragma("unroll") for (int n = 0; n < 2; ++n) { \
            v4i_t c_ = __builtin_bit_cast(v4i_t, acc[ai][bj][m][n]); \
            c_ = __builtin_amdgcn_mfma_i32_16x16x64_i8(__builtin_shufflevector(Bt[n], Bt[n], 0, 1, 2, 3), __builtin_shufflevector(At[m], At[m], 0, 1, 2, 3), c_, 0, 0, 0); \
            c_ = __builtin_amdgcn_mfma_i32_16x16x64_i8(__builtin_shufflevector(Bt[n], Bt[n], 4, 5, 6, 7), __builtin_shufflevector(At[m], At[m], 4, 5, 6, 7), c_, 0, 0, 0); \
            acc[ai][bj][m][n] = __builtin_bit_cast(f32x4, c_); } } \
        else if constexpr (FP8 == 1) { _Pragma("unroll") for (int m = 0; m < 4; ++m) _Pragma("unroll") for (int n = 0; n < 2; ++n) { \
            if (FP8_DEBUG_NONSCALED) { _Pragma("unroll") for (int q = 0; q < 4; ++q) { \
                const long ba = (long)(((unsigned long long)(unsigned)Bt[n][2 * q + 1] << 32) | (unsigned)Bt[n][2 * q]), aa = (long)(((unsigned long long)(unsigned)At[m][2 * q + 1] << 32) | (unsigned)At[m][2 * q]); \
                acc[ai][bj][m][n] = __builtin_amdgcn_mfma_f32_16x16x32_fp8_fp8(ba, aa, acc[ai][bj][m][n], 0, 0, 0); } } \
            else asm volatile("v_mfma_scale_f32_16x16x128_f8f6f4 %0, %1, %2, %0, %3, %3 op_sel_hi:[0,0,0]" : "+v"(acc[ai][bj][m][n]) : "v"(Bt[n]), "v"(At[m]), "v"(sc1)); } } \
        else { _Pragma("unroll") for (int m = 0; m < 4; ++m) _Pragma("unroll") for (int n = 0; n < 2; ++n) { \
            acc[ai][bj][m][n] = __builtin_amdgcn_mfma_f32_16x16x32_bf16(PG8_LO(Bt[n]), PG8_LO(At[m]), acc[ai][bj][m][n], 0, 0, 0); \
            acc[ai][bj][m][n] = __builtin_amdgcn_mfma_f32_16x16x32_bf16(PG8_HI(Bt[n]), PG8_HI(At[m]), acc[ai][bj][m][n], 0, 0, 0); } } \
        __builtin_amdgcn_s_setprio(0); } while (0)
#define PG8_WAIT_V(n) asm volatile("s_waitcnt vmcnt(" #n ")" ::: "memory")
#define PG8_WAIT_L(n) asm volatile("s_waitcnt lgkmcnt(" #n ")" ::: "memory")
#define PG8_BAR __builtin_amdgcn_s_barrier()
#define PG8_SCHED __builtin_amdgcn_sched_barrier(0)
    Unit cur, nxt; int ui = 0;
    if (!S.next(0, cur)) return;
    f32x4 acc[2][2][4][2];
#pragma unroll
    for (int a = 0; a < 2; ++a)
#pragma unroll
        for (int b = 0; b < 2; ++b)
#pragma unroll
            for (int m = 0; m < 4; ++m)
#pragma unroll
                for (int n = 0; n < 2; ++n) acc[a][b][m][n] = (f32x4){0.f, 0.f, 0.f, 0.f};
    v8i_t At[4], B0[2], B1[2];
    const unsigned sc1 = 0x7f7f7f7fu;
    const size_t sstep = (size_t)nt * (BK * 2);
    const char* cA = (const char*)g.A + (AIND ? (size_t)0 : (size_t)cur.pm * tstep) + (size_t)cur.ks * sstep; const char* cB = (const char*)g.Bt + (size_t)cur.pn * tstep + (size_t)cur.ks * sstep;
    S.a_ready(cur);
    if constexpr (AIND) { PG8_RT_FILL(0, cur); PG8_WAIT_V(0); PG8_BAR; PG8_RT_OFFS(0); }
    if constexpr (SP2) {
        PG8_STAGE(PG8_SB(0, 0), cB, voffB); PG8_STAGE(PG8_SB(0, 1), cB + hstep, voffB); PG8_STAGE_A(PG8_SA(0, 0), cA, 0); PG8_STAGE_A(PG8_SA(0, 1), cA, 1);
        if (wr == 1) PG8_BAR;
        PG8_WAIT_V(2); PG8_BAR;
        PG8_STAGE(PG8_SB(1, 0), cB + kstep, voffB); PG8_STAGE_A(PG8_SA(1, 0), cA + kstep, 0); PG8_STAGE(PG8_SB(1, 1), cB + hstep + kstep, voffB);
        PG8_WAIT_V(6); PG8_BAR;
    } else {
        PG8_STAGE(PG8_SB(0, 0), cB, voffB); PG8_STAGE_A(PG8_SA(0, 0), cA, 0); PG8_STAGE(PG8_SB(0, 1), cB + hstep, voffB); PG8_STAGE_A(PG8_SA(0, 1), cA, 1);
        if (wr == 1) PG8_BAR;
        PG8_WAIT_V(4); PG8_BAR;
        PG8_STAGE(PG8_SB(1, 0), cB + kstep, voffB); PG8_STAGE_A(PG8_SA(1, 0), cA + kstep, 0); PG8_STAGE(PG8_SB(1, 1), cB + hstep + kstep, voffB);
        PG8_WAIT_V(6); PG8_BAR;
    }
    for (;;) {
        const bool has_next = S.next(ui + 1, nxt);
        if constexpr (AIND) { if (has_next) PG8_RT_FILL((ui + 1) & 1, nxt); }
        const char* nA = has_next ? (const char*)g.A + (AIND ? (size_t)0 : (size_t)nxt.pm * tstep) + (size_t)nxt.ks * sstep : cA; const char* nB = has_next ? (const char*)g.Bt + (size_t)nxt.pn * tstep + (size_t)nxt.ks * sstep : cB;
#pragma clang loop unroll(disable)
        for (int t = 0; t < nt; t += 2) {
            const bool last = (t == nt - 2);
            const char* a1 = cA + (size_t)(t + 1) * kstep;
            const char* a2 = last ? nA : cA + (size_t)(t + 2) * kstep; const char* b2 = last ? nB : cB + (size_t)(t + 2) * kstep;
            const char* a3 = a2 + kstep; const char* b3 = b2 + kstep;
            if (last && has_next) S.a_ready(nxt);
            if constexpr (SP2) {
            PG8_LDB(B0, 0, 0); PG8_LDB(B1, 0, 1); PG8_SCHED; PG8_LDA(At, 0, 0); PG8_STAGE_A(PG8_SA(1, 1), a1, 1);
            if constexpr (AIND) { if (last && has_next) PG8_RT_OFFS((ui + 1) & 1); }
            PG8_WAIT_V(8); PG8_WAIT_L(0); PG8_BAR; PG8_MMA(0, 0, At, B0); PG8_MMA(0, 1, At, B1); PG8_BAR; PG8_SCHED;
            PG8_LDA(At, 0, 1); PG8_STAGE(PG8_SB(0, 0), b2, voffB); PG8_STAGE(PG8_SB(0, 1), b2 + hstep, voffB); PG8_STAGE_A(PG8_SA(0, 0), a2, 0);
            PG8_WAIT_V(8); PG8_WAIT_L(0); PG8_BAR; PG8_MMA(1, 0, At, B0); PG8_MMA(1, 1, At, B1); PG8_BAR; PG8_SCHED;
            PG8_LDB(B0, 1, 0); PG8_LDB(B1, 1, 1); PG8_SCHED; PG8_LDA(At, 1, 0); PG8_STAGE_A(PG8_SA(0, 1), a2, 1);
            PG8_WAIT_V(8); PG8_WAIT_L(0); PG8_BAR; PG8_MMA(0, 0, At, B0); PG8_MMA(0, 1, At, B1); PG8_BAR; PG8_SCHED;
            PG8_LDA(At, 1, 1); PG8_STAGE(PG8_SB(1, 0), b3, voffB); PG8_STAGE(PG8_SB(1, 1), b3 + hstep, voffB); PG8_STAGE_A(PG8_SA(1, 0), a3, 0);
            PG8_WAIT_V(8); PG8_WAIT_L(0); PG8_BAR; PG8_MMA(1, 0, At, B0); PG8_MMA(1, 1, At, B1); PG8_BAR; PG8_SCHED;
            } else {
            PG8_LDB(B0, 0, 0); PG8_SCHED; PG8_LDA(At, 0, 0); PG8_STAGE_A(PG8_SA(1, 1), a1, 1);
            if constexpr (AIND) { if (last && has_next) PG8_RT_OFFS((ui + 1) & 1); }
            PG8_WAIT_L(8); PG8_BAR; PG8_WAIT_L(0); PG8_MMA(0, 0, At, B0); PG8_BAR; PG8_SCHED;
            PG8_LDB(B1, 0, 1); PG8_STAGE(PG8_SB(0, 0), b2, voffB);
            PG8_BAR; PG8_WAIT_L(0); PG8_MMA(0, 1, At, B1); PG8_BAR;
            PG8_LDA(At, 0, 1); PG8_STAGE_A(PG8_SA(0, 0), a2, 0);
            PG8_BAR; PG8_WAIT_L(0); PG8_MMA(1, 0, At, B0); PG8_BAR; PG8_SCHED;
            PG8_STAGE(PG8_SB(0, 1), b2 + hstep, voffB);
            PG8_WAIT_V(6); PG8_BAR; PG8_MMA(1, 1, At, B1); PG8_BAR;
            PG8_LDB(B0, 1, 0); PG8_SCHED; PG8_LDA(At, 1, 0); PG8_STAGE_A(PG8_SA(0, 1), a2, 1);
            PG8_WAIT_L(8); PG8_BAR; PG8_WAIT_L(0); PG8_MMA(0, 0, At, B0); PG8_BAR; PG8_SCHED;
            PG8_LDB(B1, 1, 1); PG8_STAGE(PG8_SB(1, 0), b3, voffB);
            PG8_BAR; PG8_WAIT_L(0); PG8_MMA(0, 1, At, B1); PG8_BAR;
            PG8_LDA(At, 1, 1); PG8_STAGE_A(PG8_SA(1, 0), a3, 0);
            PG8_BAR; PG8_WAIT_L(0); PG8_MMA(1, 0, At, B0); PG8_BAR; PG8_SCHED;
            PG8_STAGE(PG8_SB(1, 1), b3 + hstep, voffB);
            PG8_WAIT_V(6); PG8_BAR; PG8_MMA(1, 1, At, B1); PG8_BAR;
            }
        }
        if constexpr (FP8 == 1) asm volatile("s_nop 15\n\ts_nop 15" ::: "memory");
        if constexpr (ALIGN_EPI) { if (wr == 0) PG8_BAR; }
        if constexpr (!Epi::AFTER_DRAIN) { E(acc, cur, wr, wc, fr, fq); S.done(cur); }
        if (!has_next) break;
#pragma unroll
        for (int a = 0; a < 2; ++a)
#pragma unroll
            for (int b = 0; b < 2; ++b)
#pragma unroll
                for (int m = 0; m < 4; ++m)
#pragma unroll
                    for (int n = 0; n < 2; ++n) acc[a][b][m][n] = (f32x4){0.f, 0.f, 0.f, 0.f};
        cur = nxt; cA = nA; cB = nB; ++ui;
        if constexpr (ALIGN_EPI) { if (wr == 1) PG8_BAR; }
    }
    PG8_WAIT_V(0);
    if constexpr (!ALIGN_EPI) { if (wr == 0) PG8_BAR; }
    PG8_BAR;
    if constexpr (Epi::AFTER_DRAIN) { E.fused(acc, cur, wr, wc, fr, fq, lds, wid, lane); S.done(cur); }
#undef PG8_SA
#undef PG8_SB
#undef PG8_STAGE
#undef PG8_CAT
#undef PG8_LO
#undef PG8_HI
#undef PG8_STAGE_A
#undef PG8_RT_FILL
#undef PG8_RT_OFFS
#undef PG8_LDA
#undef PG8_LDB
#undef PG8_MMA
#undef PG8_WAIT_V
#undef PG8_WAIT_L
#undef PG8_BAR
#undef PG8_SCHED
}
}
#define GAS __attribute__((address_space(1)))
#define LAS __attribute__((address_space(3)))
typedef unsigned short bf16;
typedef unsigned v4u __attribute__((ext_vector_type(4)));
typedef float f32x4 __attribute__((ext_vector_type(4)));
typedef short bf16x8 __attribute__((ext_vector_type(8)));
typedef GAS unsigned gu32;
typedef GAS unsigned long long gu64;
#define RLX_AGENT __ATOMIC_RELAXED, __HIP_MEMORY_SCOPE_AGENT
#define LDS_WAIT() asm volatile("s_waitcnt lgkmcnt(0)" ::: "memory")
#define VM_WAIT() asm volatile("s_waitcnt vmcnt(0)" ::: "memory")
__device__ __forceinline__ unsigned long long rt() { return __builtin_amdgcn_s_memrealtime(); }
__device__ __forceinline__ unsigned f2bf(float f) { unsigned u = __builtin_bit_cast(unsigned, f); return (u + 0x7fffu + ((u >> 16) & 1u)) >> 16; }
__device__ __forceinline__ unsigned pk2(float lo, float hi) { return f2bf(lo) | (f2bf(hi) << 16); }

#define XB_TMO      128
#define XB_XCNT(j)  (256  + 64 * (j))
#define XB_XSUB(j)  (1280 + 64 * (j))
#define XB_XGEN(j)  (2304 + 64 * (j))
#define XB_TOP      3328
#define XB_TOPGEN   3392
#define XCD_BAR_WORDS 3456
#define XB_SPIN_CAP (1u << 18)

__device__ __forceinline__ unsigned xb_ld(unsigned* p)              { return __hip_atomic_load(p, __ATOMIC_RELAXED, __HIP_MEMORY_SCOPE_AGENT); }
__device__ __forceinline__ unsigned xb_add(unsigned* p, unsigned v) { return __hip_atomic_fetch_add(p, v, __ATOMIC_RELAXED, __HIP_MEMORY_SCOPE_AGENT); }
__device__ __forceinline__ unsigned xb_xcc_id() { return (unsigned)__builtin_amdgcn_s_getreg((3 << 11) | 20) & 0xFu; }
#define XB_SPIN(cond, bar) do { unsigned _sp = 0; while (cond) { __builtin_amdgcn_s_sleep(1); \
    if ((++_sp & 255u) == 0u) { if (xb_ld(&(bar)[XB_TMO])) break; if (_sp > XB_SPIN_CAP) { atomicAdd(&(bar)[XB_TMO], 1u); break; } } } } while (0)

struct XcdBarrier {
    unsigned* bar; unsigned x;
    volatile LAS unsigned* st;
};

__device__ __forceinline__ XcdBarrier xcd_barrier_post(unsigned* bar, volatile LAS unsigned* st) {
    XcdBarrier b; b.bar = bar; b.x = xb_xcc_id(); b.st = st;
    if (threadIdx.x == 0) (void)xb_add(&bar[XB_XCNT(b.x)], 1u);
    return b;
}
__device__ __forceinline__ void xcd_barrier_complete(unsigned* bar, unsigned x, unsigned& nloc, unsigned& nx) {
    const unsigned G = gridDim.x * gridDim.y * gridDim.z;
    unsigned sum, cnt, mine, sp = 0u;
    for (;;) {
        sum = 0u; cnt = 0u; mine = 0u;
#pragma unroll
        for (unsigned j = 0; j < 16; ++j) { const unsigned c = xb_ld(&bar[XB_XCNT(j)]); sum += c; cnt += (c > 0u) ? 1u : 0u; mine = (j == x) ? c : mine; }
        if (sum == G) break;
        __builtin_amdgcn_s_sleep(1);
        if ((++sp & 255u) == 0u) { if (xb_ld(&bar[XB_TMO])) break; if (sp > XB_SPIN_CAP) { atomicAdd(&bar[XB_TMO], 1u); break; } }
    }
    nloc = mine > 0u ? mine : 1u; nx = cnt > 0u ? cnt : 1u;
}

__device__ __forceinline__ void xcd_barrier(const XcdBarrier& b) {
    asm volatile("s_waitcnt vmcnt(0)" ::: "memory");
    __syncthreads();
    if (threadIdx.x == 0) {
        unsigned* bar = b.bar;
        __builtin_amdgcn_s_waitcnt(0);
        unsigned nloc = b.st[0], nx = b.st[1];
        if (nloc == 0u) { xcd_barrier_complete(bar, b.x, nloc, nx); b.st[0] = nloc; b.st[1] = nx; }
        const unsigned old = xb_add(&bar[XB_XSUB(b.x)], 1u);
        const unsigned gen = old / nloc;
        if (old + 1u == (gen + 1u) * nloc) {
            __builtin_amdgcn_fence(__ATOMIC_RELEASE, "agent");
            asm volatile("s_waitcnt vmcnt(0)" ::: "memory");
            const unsigned og = xb_add(&bar[XB_TOP], 1u);
            const unsigned tg = og / nx;
            if (og + 1u == (tg + 1u) * nx) xb_add(&bar[XB_TOPGEN], 1u);
            else XB_SPIN(xb_ld(&bar[XB_TOPGEN]) == tg, bar);
            __builtin_amdgcn_fence(__ATOMIC_ACQUIRE, "agent");
            xb_add(&bar[XB_XGEN(b.x)], 1u);
            asm volatile("s_waitcnt vmcnt(0)" ::: "memory");
        } else {
            XB_SPIN(xb_ld(&bar[XB_XGEN(b.x)]) == gen, bar);
            __builtin_amdgcn_fence(__ATOMIC_ACQUIRE, "agent");
            asm volatile("s_waitcnt vmcnt(0)" ::: "memory");
        }
    }
    __syncthreads();
}

constexpr int NWAVES = 8, NTHR = 512;
constexpr int T = 16384, D = 1024, SEQ = 4096, NB = 4;
constexpr int FF = 2816, FFE = 3584, NE = 8;
constexpr int NKVQ = 9216;
constexpr float EPS = 1e-6f;
constexpr float QSCALE = 0.125f * 1.4426950408889634f;
constexpr size_t MiB = 1u << 20;
constexpr size_t WS_CTL = 0, CTL_ZERO_BYTES = 64 * 1024;
constexpr size_t WS_TAB = 2 * MiB;
constexpr size_t WS_COS = WS_TAB, WS_SIN = WS_TAB + 512 * 1024, WS_LB = WS_TAB + 1 * MiB, WS_SS0 = WS_LB + 64 * 1024, WS_SS3 = WS_SS0 + 64 * 1024;
constexpr size_t WS_TOKE = WS_TAB + 1 * MiB + 256 * 1024, WS_TOKP = WS_TOKE + 128 * 1024, WS_TOKW = WS_TOKP + 128 * 1024, WS_TOKD = WS_TOKW + 128 * 1024;
constexpr size_t WS_SSS = WS_TOKD + 128 * 1024  , WS_WSORT = WS_TAB + 2 * MiB, WS_DECAY = WS_TAB + 3 * MiB  ;
constexpr size_t WS_SS1 = WS_TAB + 4 * MiB, WS_SS2 = WS_TAB + 5 * MiB;
constexpr size_t WS_QZVG = 8 * MiB;
constexpr size_t WS_KVT = 136 * MiB;
constexpr size_t WS_ST = 200 * MiB;
constexpr size_t WS_OH = 264 * MiB;
constexpr size_t WS_ACTF = 8 * MiB;
constexpr size_t WS_KVQ = 8 * MiB;
constexpr size_t WS_OA = 296 * MiB;
constexpr size_t WS_LSE = 392 * MiB;
constexpr size_t WS_WGU = 8 * MiB;
constexpr size_t WS_WD = 64 * MiB;
constexpr size_t WS_ASORT = 92 * MiB;
constexpr size_t WS_Y = 126 * MiB;
constexpr size_t WS_ACTM = 194 * MiB;
constexpr float I8_SA = 21.0f  , I8_SW = 880.f  ;
constexpr float FP8_SA = 16.f, FP8_SW1 = 64.f, FP8_SACT = 8.f, FP8_SW2 = 128.f;
constexpr size_t WS_WS = 400 * MiB;
constexpr size_t WS_WIN = WS_WS, WS_WOH = WS_WIN + 8 * MiB, WS_WFGU = WS_WOH + 2 * MiB, WS_WFD = WS_WFGU + 11 * MiB, WS_WKVQ = WS_WFD + 6 * MiB, WS_WOD = WS_WKVQ + 18 * MiB;
constexpr size_t WS_HB = 448 * MiB;
constexpr size_t WS_END = 482 * MiB;
static_assert(WS_SS2 + 1 * MiB <= WS_QZVG && WS_WOD + 2 * MiB <= WS_HB && WS_ACTM + (size_t)34816 * 3584 <= WS_WS && WS_LSE + 3 * MiB <= WS_WS, "ws map");
constexpr int MAXROWS = 34816, PART_ROWS = 2048;

constexpr int CW_TMO = 0, CW_CODE = 1, CW_BAR = 1024  , CW_CNT = 8192;
static_assert((CW_BAR + 2 * 3456) <= CW_CNT && (CW_CNT + 8 * 64) * 4 <= (int)CTL_ZERO_BYTES, "every control word lies inside the per-call memset");

constexpr int RING_OFF = 0, RING_BYTES = 131072;
constexpr int LDSCTL_OFF = RING_BYTES, MISC_OFF = LDSCTL_OFF + 320;
constexpr int LDS_BYTES = 147456;

__device__ __forceinline__ float bf2f(unsigned short b) { return __uint_as_float(((unsigned)b) << 16); }
__device__ __forceinline__ float bflo(unsigned w) { return __uint_as_float(w << 16); }
__device__ __forceinline__ float bfhi(unsigned w) { return __uint_as_float(w & 0xffff0000u); }
__device__ __forceinline__ float wave_sum(float v) {
#pragma unroll
    for (int o = 1; o < 64; o <<= 1) v += __shfl_xor(v, o);
    return v;
}
__device__ __forceinline__ float wave_max(float v) {
#pragma unroll
    for (int o = 1; o < 64; o <<= 1) v = fmaxf(v, __shfl_xor(v, o));
    return v;
}

__device__ __forceinline__ void transpose_item(const float* W, int ldw, int K, const float* gain, bf16* WT, int map, int row_off, LAS float* scr, int kb, int nb, int lane) {
    const int k0 = 64 * kb, n0 = 32 * nb;
    float wv[32];
#pragma unroll
    for (int i = 0; i < 32; ++i) { const int kk = 2 * i + (lane >> 5); wv[i] = W[(size_t)(k0 + kk) * ldw + n0 + (lane & 31)]; }
#pragma unroll
    for (int i = 0; i < 32; ++i) { const int kk = 2 * i + (lane >> 5); const float gk = gain ? gain[k0 + kk] : 1.0f; scr[kk * 33 + (lane & 31)] = wv[i] * gk; }
    LDS_WAIT(); asm volatile("" ::: "memory");
    const int c = lane & 7;
#pragma unroll
    for (int j = 0; j < 4; ++j) { const int n = (lane >> 3) + 8 * j; const LAS float* s = scr + (8 * c) * 33 + n;
        v4u o; o.x = pk2(s[0 * 33], s[1 * 33]); o.y = pk2(s[2 * 33], s[3 * 33]); o.z = pk2(s[4 * 33], s[5 * 33]); o.w = pk2(s[6 * 33], s[7 * 33]);
        const int nn = n0 + n; int dr = nn;
        if (map == 1) dr = ((nn >> 7) << 8) + (nn & 127);
        if (map == 2) { const int d = nn & 63; dr = (nn & ~63) + 8 * ((d & 31) >> 2) + 4 * (d >> 5) + (d & 3); }
        *(GAS v4u*)(WT + (size_t)(row_off + dr) * K + k0 + 8 * c) = o; }
    LDS_WAIT(); asm volatile("" ::: "memory");
}


typedef short s16x4 __attribute__((ext_vector_type(4)));
typedef float f32x16 __attribute__((ext_vector_type(16)));
typedef float f32x2_t __attribute__((ext_vector_type(2)));
typedef __bf16 bf16x2_t __attribute__((ext_vector_type(2)));
typedef short v4i16_t __attribute__((ext_vector_type(4)));
#define MFMA32(a, b, c) __builtin_amdgcn_mfma_f32_32x32x16_bf16((a), (b), (c), 0, 0, 0)
__device__ __forceinline__ unsigned cvtpk(float lo, float hi) { f32x2_t v = {lo, hi}; bf16x2_t b = __builtin_convertvector(v, bf16x2_t); return __builtin_bit_cast(unsigned, b); }
__device__ __forceinline__ int crow(int r, int hi) { return (r & 3) + 8 * (r >> 2) + 4 * hi; }
__device__ __forceinline__ s16x4 trd(const LAS char* p) { return __builtin_bit_cast(s16x4, __builtin_amdgcn_ds_read_tr16_b64_v4i16((LAS v4i16_t*)p)); }
__device__ __forceinline__ bf16x8 trpair(const LAS char* p0, const LAS char* p1) { const s16x4 lo = trd(p0), hi = trd(p1); return __builtin_shufflevector(lo, hi, 0, 1, 2, 3, 4, 5, 6, 7); }
#define PACK8(x, s) __builtin_bit_cast(bf16x8, (v4u){cvtpk((x)[8 * (s)], (x)[8 * (s) + 1]), cvtpk((x)[8 * (s) + 2], (x)[8 * (s) + 3]), cvtpk((x)[8 * (s) + 4], (x)[8 * (s) + 5]), cvtpk((x)[8 * (s) + 6], (x)[8 * (s) + 7])})

__device__ __forceinline__ void transpose_item8(const float* W, int ldw, int K, const float* gain, float scale, unsigned char* WT, int map, int row_off, LAS float* scr, int kb, int nb, int lane) {
    const int k0 = 64 * kb, n0 = 32 * nb;
    float wv[32];
#pragma unroll
    for (int i = 0; i < 32; ++i) { const int kk = 2 * i + (lane >> 5); wv[i] = W[(size_t)(k0 + kk) * ldw + n0 + (lane & 31)]; }
#pragma unroll
    for (int i = 0; i < 32; ++i) { const int kk = 2 * i + (lane >> 5); const float gk = gain ? gain[k0 + kk] * scale : scale; scr[kk * 33 + (lane & 31)] = wv[i] * gk; }
    LDS_WAIT(); asm volatile("" ::: "memory");
    const int c = lane & 3;
#pragma unroll
    for (int j = 0; j < 2; ++j) { const int n = (lane >> 2) + 16 * j; const LAS float* s = scr + (16 * c) * 33 + n;
        v4u o; o.x = pg8::pk4_fp8(s[0 * 33], s[1 * 33], s[2 * 33], s[3 * 33]); o.y = pg8::pk4_fp8(s[4 * 33], s[5 * 33], s[6 * 33], s[7 * 33]);
        o.z = pg8::pk4_fp8(s[8 * 33], s[9 * 33], s[10 * 33], s[11 * 33]); o.w = pg8::pk4_fp8(s[12 * 33], s[13 * 33], s[14 * 33], s[15 * 33]);
        const int nn = n0 + n; int dr = nn;
        if (map == 1) dr = ((nn >> 7) << 8) + (nn & 127);
        if (map == 2) { const int d = nn & 63; dr = (nn & ~63) + 8 * ((d & 31) >> 2) + 4 * (d >> 5) + (d & 3); }
        *(GAS v4u*)(WT + (size_t)(row_off + dr) * K + k0 + 16 * c) = o; }
    LDS_WAIT(); asm volatile("" ::: "memory");
}

__device__ __forceinline__ void transpose_item_i8(const float* W, int ldw, int K, const float* gain, float scale, unsigned char* WT, int map, int row_off, LAS float* scr, int kb, int nb, int lane) {
    const int k0 = 64 * kb, n0 = 32 * nb;
    float wv[32];
#pragma unroll
    for (int i = 0; i < 32; ++i) { const int kk = 2 * i + (lane >> 5); wv[i] = W[(size_t)(k0 + kk) * ldw + n0 + (lane & 31)]; }
#pragma unroll
    for (int i = 0; i < 32; ++i) { const int kk = 2 * i + (lane >> 5); const float gk = gain ? gain[k0 + kk] * scale : scale; scr[kk * 33 + (lane & 31)] = wv[i] * gk; }
    LDS_WAIT(); asm volatile("" ::: "memory");
    const int c = lane & 3;
#pragma unroll
    for (int j = 0; j < 2; ++j) { const int n = (lane >> 2) + 16 * j; const LAS float* s = scr + (16 * c) * 33 + n;
        v4u o; o.x = pg8::pk4_i8(s[0 * 33], s[1 * 33], s[2 * 33], s[3 * 33]); o.y = pg8::pk4_i8(s[4 * 33], s[5 * 33], s[6 * 33], s[7 * 33]);
        o.z = pg8::pk4_i8(s[8 * 33], s[9 * 33], s[10 * 33], s[11 * 33]); o.w = pg8::pk4_i8(s[12 * 33], s[13 * 33], s[14 * 33], s[15 * 33]);
        const int nn = n0 + n; int dr = nn;
        if (map == 1) dr = ((nn >> 7) << 8) + (nn & 127);
        *(GAS v4u*)(WT + (size_t)(row_off + dr) * K + k0 + 16 * c) = o; }
    LDS_WAIT(); asm volatile("" ::: "memory");
}

struct Args { const float* in[19]; float* out; unsigned char* ws; int ph_lo, ph_hi, li, pad; };
constexpr int NPHASE = 17;

__global__ void __launch_bounds__(NTHR, 2) fwd_kernel(Args args) {
    extern __shared__ __attribute__((aligned(16))) unsigned char lds_raw[];
    LAS unsigned char* lds = (LAS unsigned char*)lds_raw;
    volatile LAS unsigned* MISC = (volatile LAS unsigned*)(lds + MISC_OFF);
    const int tid = threadIdx.x, lane = tid & 63, wave = __builtin_amdgcn_readfirstlane(tid >> 6);
    const int G = gridDim.x, bid = blockIdx.x;
    const int gw = bid * NWAVES + wave, NGW = G * NWAVES;
#define ctl ((gu32*)(args.ws + WS_CTL))
    const int lo = args.ph_lo, hi = args.ph_hi;
    for (int u = tid; u < (LDS_BYTES - LDSCTL_OFF) / 4; u += NTHR) ((LAS unsigned*)(lds + LDSCTL_OFF))[u] = 0u;
    __syncthreads();
    XcdBarrier bar; bar.bar = (unsigned*)(ctl + CW_BAR) + args.li * XCD_BAR_WORDS; bar.x = 0; bar.st = nullptr;
    if (hi - lo > 1) bar = xcd_barrier_post((unsigned*)(ctl + CW_BAR) + args.li * XCD_BAR_WORDS, MISC + 8);
#define IN(k) (lo <= (k) && (k) < hi)
#if defined(PROBE_NOSTORE)
#define PROBE_SKIP(k) ((args.li == 1 && lo == (k)) ? PROBE_NOSTORE : 0)
#else
#define PROBE_SKIP(k) 0
#endif
#define SEAM(k) do { if (IN(k) && IN((k) + 1)) xcd_barrier(bar); } while (0)
#define RSTD_TABLE(S_, ssptr_, slots_) LAS float* rsl_ = (LAS float*)(lds + LDSCTL_OFF + 2048); const unsigned rsl = (unsigned)(size_t)rsl_; int pml = -1; { pg8::Unit u0_; if (S_.next(0, u0_)) pml = u0_.pm; \
        if (pml >= 0 && tid < 256) { const int row_ = pml * 256 + tid; const float ssv_ = (slots_) ? pg8::row_ss<true>(ssptr_, row_) : pg8::row_ss<false>(ssptr_, row_); rsl_[tid] = __builtin_amdgcn_rsqf(ssv_ * (1.0f / 1024.0f) + EPS); } \
        __syncthreads(); }
#ifndef F8_SP2
#define F8_SP2 true
#endif
#ifndef MOE_ALIGN
#define MOE_ALIGN true
#endif
#ifndef STAGGER_TICKS
#define STAGGER_TICKS 0
#endif
#ifndef STAGGER1_TICKS
#define STAGGER1_TICKS 0
#endif
#define STAGGER1() do { if (STAGGER1_TICKS) { const unsigned long long t0_ = __builtin_amdgcn_s_memrealtime(); const unsigned long long d_ = (unsigned long long)(((bid >> 3) & 3) * STAGGER1_TICKS); while (__builtin_amdgcn_s_memrealtime() - t0_ < d_) __builtin_amdgcn_s_sleep(8); } } while (0)
#define STAGGER() do { if (STAGGER_TICKS) { const unsigned long long t0_ = __builtin_amdgcn_s_memrealtime(); const unsigned long long d_ = (unsigned long long)(((bid >> 3) & 3) * STAGGER_TICKS); while (__builtin_amdgcn_s_memrealtime() - t0_ < d_) __builtin_amdgcn_s_sleep(8); } } while (0)

#define xin ((const float*)(args.in[0]))
#define attn_norm ((const float*)(args.in[1]))
#define ffn_norm ((const float*)(args.in[2]))
#define hgrn_w_in ((const float*)(args.in[3]))
#define hgrn_lb ((const float*)(args.in[4]))
#define hgrn_onorm ((const float*)(args.in[5]))
#define hgrn_w_out ((const float*)(args.in[6]))
#define kv_norm ((const float*)(args.in[7]))
#define w_kv ((const float*)(args.in[8]))
#define dil_w_q ((const float*)(args.in[9]))
#define dil_w_out ((const float*)(args.in[10]))
#define ffn_wg ((const float*)(args.in[11]))
#define ffn_wu ((const float*)(args.in[12]))
#define ffn_wd ((const float*)(args.in[13]))
#define moe_wr ((const float*)(args.in[14]))
#define moe_wg ((const float*)(args.in[15]))
#define moe_wu ((const float*)(args.in[16]))
#define moe_wd ((const float*)(args.in[17]))
#define final_norm ((const float*)(args.in[18]))
#define hf ((float*)(args.out))
#define hb ((bf16*)((bf16*)(args.ws + WS_HB)))
#define hb8 ((unsigned char*)(args.ws + WS_WIN))
#define hbi8 ((unsigned char*)(args.ws + WS_KVT))
#define W_in8 ((unsigned char*)(args.ws + WS_WIN))
#define xq8 ((unsigned char*)(args.ws + WS_KVT))
#define ypart ((bf16*)(args.ws + WS_ASORT))
#define a8tok ((unsigned char*)(args.ws + WS_ASORT))
#define rowtok ((int*)(args.ws + WS_ASORT + 20 * MiB))
#define W_od8 ((unsigned char*)(args.ws + WS_WOD))
#define oa8 ((unsigned char*)(args.ws + WS_LSE + 3 * MiB))
#define W_kvq8 ((unsigned char*)(args.ws + WS_WKVQ))
#define W_fgu8 ((unsigned char*)(args.ws + WS_WFGU))
#define W_fd8 ((unsigned char*)(args.ws + WS_WFD))
#define actf8 ((unsigned char*)(args.ws + WS_ACTF))
#define cosT ((float*)((float*)(args.ws + WS_COS)))
#define sinT ((float*)((float*)(args.ws + WS_SIN)))
#define lbv ((float*)((float*)(args.ws + WS_LB)))
#define ss0 ((float*)((float*)(args.ws + WS_SS0)))
#define ss1 ((float*)((float*)(args.ws + WS_SS1)))
#define ss2 ((float*)((float*)(args.ws + WS_SS2)))
#define ss3 ((float*)((float*)(args.ws + WS_SS3)))
#define W_in ((bf16*)((bf16*)(args.ws + WS_WIN)))
#define W_oh ((bf16*)((bf16*)(args.ws + WS_WOH)))
#define W_fgu ((bf16*)((bf16*)(args.ws + WS_WFGU)))
#define W_fd ((bf16*)((bf16*)(args.ws + WS_WFD)))
#define W_kvq ((bf16*)((bf16*)(args.ws + WS_WKVQ)))
#define W_od ((bf16*)((bf16*)(args.ws + WS_WOD)))
#define W_gu ((unsigned char*)(args.ws + WS_WGU))
#define W_d ((unsigned char*)(args.ws + WS_WD))
#define qzvg ((bf16*)((bf16*)(args.ws + WS_QZVG)))
#define kvT ((bf16*)((bf16*)(args.ws + WS_KVT)))
#define stT ((bf16*)((bf16*)(args.ws + WS_ST)))
#define oh ((bf16*)((bf16*)(args.ws + WS_OH)))
#define actf ((bf16*)((bf16*)(args.ws + WS_ACTF)))
#define kvq ((bf16*)((bf16*)(args.ws + WS_KVQ)))
#define kvq8 ((const unsigned char*)(args.ws + WS_KVQ))
#define oa ((bf16*)((bf16*)(args.ws + WS_OA)))
#define asort ((unsigned char*)(args.ws + WS_ASORT))
#define actm ((unsigned char*)(args.ws + WS_ACTM))
#define ymoe ((bf16*)((bf16*)(args.ws + WS_Y)))
#define decay ((float*)((float*)(args.ws + WS_DECAY)))
#define tok_e ((int*)((int*)(args.ws + WS_TOKE)))
#define tok_p ((int*)((int*)(args.ws + WS_TOKP)))
#define tok_w ((float*)((float*)(args.ws + WS_TOKW)))
#define tok_d ((int*)((int*)(args.ws + WS_TOKD)))
#define ss_sorted ((float*)((float*)(args.ws + WS_SSS)))
#define w_sorted ((float*)((float*)(args.ws + WS_WSORT)))
    if (IN(0)) {
        LAS float* scr = (LAS float*)(lds + RING_OFF + wave * 16384);
        constexpr int I_IN = 16 * 128, I_OH = 16 * 32, I_FG = 16 * 88, I_FD = 44 * 32, I_KV = 16 * 96;
        constexpr int NIT = I_IN + I_OH + 2 * I_FG + I_FD + 3 * I_KV + I_OH;
        for (int it = gw; it < NIT; it += NGW) {
            int r = it;
            if (r < I_IN) { transpose_item(hgrn_w_in, 4096, 1024, attn_norm, W_in, 0, 0, scr, r / 128, r % 128, lane); continue; } r -= I_IN;
            if (r < I_OH) { transpose_item(hgrn_w_out, 1024, 1024, nullptr, W_oh, 0, 0, scr, r / 32, r % 32, lane); continue; } r -= I_OH;
            if (r < I_FG) { transpose_item_i8(ffn_wg, FF, 1024, ffn_norm, I8_SW, W_fgu8, 1, 0, scr, r / 88, r % 88, lane); continue; } r -= I_FG;
            if (r < I_FG) { transpose_item_i8(ffn_wu, FF, 1024, ffn_norm, I8_SW, W_fgu8, 1, 128, scr, r / 88, r % 88, lane); continue; } r -= I_FG;
            if (r < I_FD) { transpose_item(ffn_wd, 1024, FF, nullptr, W_fd, 0, 0, scr, r / 32, r % 32, lane); continue; } r -= I_FD;
            if (r < I_KV) { transpose_item8(w_kv, 6144, 1024, kv_norm, FP8_SW1, W_kvq8, 2, 0, scr, r / 96, r % 96, lane); continue; } r -= I_KV;
            if (r < I_KV) { transpose_item8(w_kv + 3072, 6144, 1024, kv_norm, FP8_SW1, W_kvq8, 0, 3072, scr, r / 96, r % 96, lane); continue; } r -= I_KV;
            if (r < I_KV) { transpose_item8(dil_w_q, 3072, 1024, attn_norm + 1024, FP8_SW1, W_kvq8, 2, 6144, scr, r / 96, r % 96, lane); continue; } r -= I_KV;
            transpose_item8(dil_w_out, 1024, 1024, nullptr, FP8_SW1, W_od8, 0, 0, scr, r / 32, r % 32, lane);
        }
        for (int m = gw; m < T; m += NGW) {
            const GAS f32x4* xr = (const GAS f32x4*)(xin + (size_t)m * D) + lane; f32x4 v[4]; float s = 0.f;
#pragma unroll
            for (int j = 0; j < 4; ++j) { v[j] = xr[64 * j]; s += (v[j].x * v[j].x + v[j].y * v[j].y) + (v[j].z * v[j].z + v[j].w * v[j].w); }
            s = wave_sum(s);
            GAS unsigned long long* o8 = (GAS unsigned long long*)(hb + (size_t)m * D) + lane;
#pragma unroll
            for (int j = 0; j < 4; ++j) o8[64 * j] = (unsigned long long)pk2(v[j].x, v[j].y) | ((unsigned long long)pk2(v[j].z, v[j].w) << 32);
            if (lane == 0) ss0[m] = s;
        }
        for (int i = bid * NTHR + tid; i < SEQ * 32; i += G * NTHR) {
            const int pos = i >> 5, j = i & 31;
            const float inv = (float)exp2(-(double)j * (13.287712379549449 / 32.0));
            const float ang = (float)pos * inv;
            const double rev = (double)ang * 0.15915494309189535; const float fr = (float)(rev - floor(rev));
            cosT[i] = __builtin_amdgcn_cosf(fr); sinT[i] = __builtin_amdgcn_sinf(fr);
        }
        for (int i = bid * NTHR + tid; i < 1024; i += G * NTHR) lbv[i] = 1.0f / (1.0f + __expf(hgrn_lb[1024 + i] - hgrn_lb[i]));
    }
    SEAM(0);
#if defined(PROBE_BARRIERS)
    if (hi - lo > 1) for (int rr = 0; rr < PROBE_BARRIERS; ++rr) xcd_barrier(bar);
#endif

    if (IN(1)) {
        pg8::Gemm g{hb, W_in, T, 4096, 1024, 0, nullptr, 0}; pg8::StaticOrder S; S.init(T, 4096, G, bid);
        RSTD_TABLE(S, ss0, false)
        pg8::EpiScale<0, false> E{qzvg, 4096, ss0, nullptr, nullptr, 1.f, PROBE_SKIP(1), 1.0f, rsl, pml};
        STAGGER();
        pg8::gemm_phase<pg8::EpiScale<0, false>, pg8::StaticOrder, true, true>(lds + RING_OFF, g, S, E);
    }
    SEAM(1);

    if (IN(2)) {
        constexpr int PB = 272;
        LAS char* kE = (LAS char*)(lds);
        LAS char* vI = (LAS char*)(lds + 17408);
        LAS float* tot = (LAS float*)(lds + 34816);
        const int dp = tid & 63, seg = tid >> 6, r32 = lane & 31, hh = lane >> 5;
        const int troff = ((lane & 15) >> 2) * PB + (16 * ((lane >> 4) & 1) + 4 * (lane & 3)) * 2;
        const int d0 = 2 * dp;
        unsigned zreg[8], vreg[8];
#define HG2_LOAD(unit_) do { const int b_ = (unit_) >> 9, h_ = ((unit_) >> 6) & 7, c_ = (unit_) & 63; const bf16* rp_ = qzvg + ((size_t)b_ * SEQ + c_ * 64 + 8 * seg) * 4096 + h_ * 128 + d0; \
            _Pragma("unroll") for (int i = 0; i < 8; ++i) { zreg[i] = *(const unsigned*)(rp_ + (size_t)i * 4096 + 1024); vreg[i] = *(const unsigned*)(rp_ + (size_t)i * 4096 + 2048); } } while (0)
        if (bid < 2048) HG2_LOAD(bid);
        for (int unit = bid; unit < 2048; unit += G) {
            const int h = (unit >> 6) & 7;
            const float lb0 = lbv[h * 128 + d0], lb1 = lbv[h * 128 + d0 + 1];
            float bl0[8], bl1[8], k0[8], k1[8]; float run0 = 1.f, run1 = 1.f;
#pragma unroll
            for (int i = 0; i < 8; ++i) { const int t = 8 * seg + i; const unsigned zz = zreg[i];
                const float e0 = __expf(-bflo(zz)), e1 = __expf(-bfhi(zz)), ri0 = __builtin_amdgcn_rcpf(1.f + e0), ri1 = __builtin_amdgcn_rcpf(1.f + e1);
                const float f0 = (1.f + lb0 * e0) * ri0, f1 = (1.f + lb1 * e1) * ri1;
                run0 *= f0; run1 *= f1; bl0[i] = run0; bl1[i] = run1; k0[i] = (1.f - lb0) * e0 * ri0; k1[i] = (1.f - lb1) * e1 * ri1;
                *(LAS unsigned*)(vI + t * PB + d0 * 2) = vreg[i]; }
            if (unit + G < 2048) HG2_LOAD(unit + G);
            tot[seg * 128 + d0] = run0; tot[seg * 128 + d0 + 1] = run1;
            __syncthreads();
            float pre0 = 1.f, pre1 = 1.f, all0 = 1.f, all1 = 1.f;
#pragma unroll
            for (int s = 0; s < 8; ++s) { const float a = tot[s * 128 + d0], bq = tot[s * 128 + d0 + 1]; all0 *= a; all1 *= bq; if (s < seg) { pre0 *= a; pre1 *= bq; } }
#pragma unroll
            for (int i = 0; i < 8; ++i) { const int t = 8 * seg + i;
                *(LAS unsigned*)(kE + t * PB + d0 * 2) = cvtpk(k0[i] * all0 * __builtin_amdgcn_rcpf(pre0 * bl0[i]), k1[i] * all1 * __builtin_amdgcn_rcpf(pre1 * bl1[i])); }
            if (seg == 0) { decay[unit * 128 + d0] = all0; decay[unit * 128 + d0 + 1] = all1; }
            __syncthreads();
            {
                const int dt = wave & 3, vt0 = 2 * (wave >> 2);
                f32x16 A0, A1;
#pragma unroll
                for (int i = 0; i < 16; ++i) { A0[i] = 0.f; A1[i] = 0.f; }
#pragma unroll
                for (int ks = 0; ks < 4; ++ks) { const int rb = (16 * ks + 8 * hh) * PB + troff;
                    const bf16x8 ka = trpair(kE + rb + 64 * dt, kE + rb + 4 * PB + 64 * dt);
                    const bf16x8 v0 = trpair(vI + rb + 64 * vt0, vI + rb + 4 * PB + 64 * vt0), v1 = trpair(vI + rb + 64 * (vt0 + 1), vI + rb + 4 * PB + 64 * (vt0 + 1));
                    A0 = MFMA32(ka, v0, A0); A1 = MFMA32(ka, v1, A1); }
                bf16* o0 = kvT + ((size_t)unit * 128 + 32 * vt0 + r32) * 128 + 32 * dt + 4 * hh;
#pragma unroll
                for (int g = 0; g < 4; ++g) {
                    *(unsigned long long*)(o0 + 8 * g) = (unsigned long long)cvtpk(A0[4 * g], A0[4 * g + 1]) | ((unsigned long long)cvtpk(A0[4 * g + 2], A0[4 * g + 3]) << 32);
                    *(unsigned long long*)(o0 + 32 * 128 + 8 * g) = (unsigned long long)cvtpk(A1[4 * g], A1[4 * g + 1]) | ((unsigned long long)cvtpk(A1[4 * g + 2], A1[4 * g + 3]) << 32); }
            }
            __syncthreads();
        }
#undef HG2_LOAD
    }
    SEAM(2);

    if (IN(3)) {
        for (int idx = bid * NTHR + tid; idx < 32 * 128 * 32; idx += G * NTHR) {
            const int bh = idx >> 12, v = (idx >> 5) & 127, dg = idx & 31;
            f32x4 st = (f32x4){0.f, 0.f, 0.f, 0.f};
#pragma unroll 8
            for (int c = 0; c < 64; ++c) { const size_t unit = (size_t)bh * 64 + c; const size_t o = (unit * 128 + v) * 128 + 4 * dg;
                *(unsigned long long*)(stT + o) = (unsigned long long)pk2(st[0], st[1]) | ((unsigned long long)pk2(st[2], st[3]) << 32);
                const f32x4 dc = *(const f32x4*)(decay + unit * 128 + 4 * dg); const unsigned long long kv = *(const unsigned long long*)(kvT + o);
                const unsigned klo = (unsigned)kv, khi = (unsigned)(kv >> 32);
                st[0] = dc[0] * st[0] + bflo(klo); st[1] = dc[1] * st[1] + bfhi(klo); st[2] = dc[2] * st[2] + bflo(khi); st[3] = dc[3] * st[3] + bfhi(khi); }
        }
    }
    SEAM(3);

    if (IN(4)) {
        constexpr int PB = 272;
        LAS char* qd = (LAS char*)(lds);
        LAS char* kd = (LAS char*)(lds + 17408);
        LAS char* vI = (LAS char*)(lds + 34816);
        LAS float* tot = (LAS float*)(lds + 52224);
        LAS float* ssx = (LAS float*)(lds + 56320);
        const int dp = tid & 63, seg = tid >> 6, r32 = lane & 31, hh = lane >> 5;
        const int troff = ((lane & 15) >> 2) * PB + (16 * ((lane >> 4) & 1) + 4 * (lane & 3)) * 2;
        const int vt = wave & 3, tt = wave >> 2;
        const int d0 = 2 * dp;
        unsigned qreg[8], zreg[8], vreg[8];
        f32x4 onv[4];
#pragma unroll
        for (int g = 0; g < 4; ++g) onv[g] = *(const f32x4*)(hgrn_onorm + 32 * vt + 4 * hh + 8 * g);
#define HG4_LOAD(unit_) do { const int b_ = (unit_) >> 9, h_ = ((unit_) >> 6) & 7, c_ = (unit_) & 63; const bf16* rp_ = qzvg + ((size_t)b_ * SEQ + c_ * 64 + 8 * seg) * 4096 + h_ * 128 + d0; \
            _Pragma("unroll") for (int i = 0; i < 8; ++i) { qreg[i] = *(const unsigned*)(rp_ + (size_t)i * 4096); zreg[i] = *(const unsigned*)(rp_ + (size_t)i * 4096 + 1024); vreg[i] = *(const unsigned*)(rp_ + (size_t)i * 4096 + 2048); } } while (0)
        if (bid < 2048) HG4_LOAD(bid);
        for (int unit = bid; unit < 2048; unit += G) {
            const int b = unit >> 9, h = (unit >> 6) & 7, c = unit & 63; const size_t r0 = (size_t)b * SEQ + c * 64;
            bf16x8 sa[8]; unsigned long long gg[4];
            { const bf16* sp = stT + ((size_t)unit * 128 + 32 * vt + r32) * 128 + 8 * hh;
#pragma unroll
              for (int ks = 0; ks < 8; ++ks) sa[ks] = *(const bf16x8*)(sp + 16 * ks);
              const bf16* gp = qzvg + (r0 + 32 * tt + r32) * 4096 + 3072 + h * 128 + 32 * vt + 4 * hh;
#pragma unroll
              for (int g = 0; g < 4; ++g) gg[g] = *(const unsigned long long*)(gp + 8 * g); }
            const float lb0 = lbv[h * 128 + d0], lb1 = lbv[h * 128 + d0 + 1];
            float bl0[8], bl1[8], k0[8], k1[8], q0[8], q1[8]; float run0 = 1.f, run1 = 1.f;
#pragma unroll
            for (int i = 0; i < 8; ++i) { const int t = 8 * seg + i; const unsigned qq = qreg[i], zz = zreg[i];
                const float e0 = __expf(-bflo(zz)), e1 = __expf(-bfhi(zz)), ri0 = __builtin_amdgcn_rcpf(1.f + e0), ri1 = __builtin_amdgcn_rcpf(1.f + e1);
                const float f0 = (1.f + lb0 * e0) * ri0, f1 = (1.f + lb1 * e1) * ri1;
                run0 *= f0; run1 *= f1; bl0[i] = run0; bl1[i] = run1; k0[i] = (1.f - lb0) * e0 * ri0; k1[i] = (1.f - lb1) * e1 * ri1; q0[i] = bflo(qq); q1[i] = bfhi(qq);
                *(LAS unsigned*)(vI + t * PB + d0 * 2) = vreg[i]; }
            if (unit + G < 2048) HG4_LOAD(unit + G);
            tot[seg * 128 + d0] = run0; tot[seg * 128 + d0 + 1] = run1;
            __syncthreads();
            float pre0 = 1.f, pre1 = 1.f;
#pragma unroll
            for (int s = 0; s < 8; ++s) { if (s < seg) { pre0 *= tot[s * 128 + d0]; pre1 *= tot[s * 128 + d0 + 1]; } }
#pragma unroll
            for (int i = 0; i < 8; ++i) { const int t = 8 * seg + i;
                const float x0 = pre0 * bl0[i], x1 = pre1 * bl1[i];
                *(LAS unsigned*)(qd + t * PB + d0 * 2) = cvtpk(q0[i] * x0, q1[i] * x1);
                *(LAS unsigned*)(kd + t * PB + d0 * 2) = cvtpk(k0[i] * __builtin_amdgcn_rcpf(x0), k1[i] * __builtin_amdgcn_rcpf(x1)); }
            __syncthreads();
            f32x16 O;
            {
                bf16x8 qf[8];
#pragma unroll
                for (int ks = 0; ks < 8; ++ks) qf[ks] = *(const LAS bf16x8*)(qd + (32 * tt + r32) * PB + (16 * ks + 8 * hh) * 2);
#pragma unroll
                for (int i = 0; i < 16; ++i) O[i] = 0.f;
#pragma unroll
                for (int ks = 0; ks < 8; ++ks) O = MFMA32(sa[ks], qf[ks], O);
#pragma unroll
                for (int st = 0; st < 2; ++st) {
                    if (st <= tt) {
                        f32x16 ST;
#pragma unroll
                        for (int i = 0; i < 16; ++i) ST[i] = 0.f;
#pragma unroll
                        for (int ks = 0; ks < 8; ++ks) { const bf16x8 ka = *(const LAS bf16x8*)(kd + (32 * st + r32) * PB + (16 * ks + 8 * hh) * 2); ST = MFMA32(ka, qf[ks], ST); }
                        if (st == tt) {
#pragma unroll
                            for (int i = 0; i < 16; ++i) ST[i] = (crow(i, hh) <= r32) ? ST[i] : 0.f; }
#pragma unroll
                        for (int s2 = 0; s2 < 2; ++s2) { const bf16x8 pb = PACK8(ST, s2);
                            const LAS char* rb = vI + (32 * st + 16 * s2 + 4 * hh) * PB + 64 * vt + troff;
                            const bf16x8 va = trpair(rb, rb + 8 * PB);
                            O = MFMA32(va, pb, O); }
                    }
                }
                float ssq = 0.f;
#pragma unroll
                for (int i = 0; i < 16; ++i) ssq += O[i] * O[i];
                ssq += __shfl_xor(ssq, 32);
                if (hh == 0) ssx[vt * 64 + 32 * tt + r32] = ssq;
            }
            __syncthreads();
            {
                const int t = 32 * tt + r32;
                const float tsum = (ssx[t] + ssx[64 + t]) + (ssx[128 + t] + ssx[192 + t]);
                const float rn = __builtin_amdgcn_rsqf(tsum * (1.f / 128.f) + EPS);
                bf16* op = oh + (r0 + t) * 1024 + h * 128 + 32 * vt + 4 * hh;
#pragma unroll
                for (int g = 0; g < 4; ++g) { const unsigned long long g8 = gg[g]; const f32x4 on = onv[g];
                    const float g0 = bflo((unsigned)g8), g1 = bfhi((unsigned)g8), g2 = bflo((unsigned)(g8 >> 32)), g3 = bfhi((unsigned)(g8 >> 32));
                    const float y0 = O[4 * g] * rn * on[0] * (g0 * __builtin_amdgcn_rcpf(1.f + __expf(-g0))), y1 = O[4 * g + 1] * rn * on[1] * (g1 * __builtin_amdgcn_rcpf(1.f + __expf(-g1)));
                    const float y2 = O[4 * g + 2] * rn * on[2] * (g2 * __builtin_amdgcn_rcpf(1.f + __expf(-g2))), y3 = O[4 * g + 3] * rn * on[3] * (g3 * __builtin_amdgcn_rcpf(1.f + __expf(-g3)));
                    *(unsigned long long*)(op + 8 * g) = (unsigned long long)cvtpk(y0, y1) | ((unsigned long long)cvtpk(y2, y3) << 32); }
            }
            __syncthreads();
        }
#undef HG4_LOAD
    }
    SEAM(4);

    if (IN(5)) {
        pg8::Gemm g{oh, W_oh, T, 1024, 1024, 0, nullptr, 0}; pg8::StaticOrder S; S.init(T, 1024, G, bid);
        pg8::EpiResid<true, true, false, true, 2> E{hb, nullptr, PROBE_SKIP(5) ? (bf16*)(args.ws + WS_QZVG) : hb, PROBE_SKIP(5) ? (unsigned char*)(args.ws + WS_QZVG + 64 * MiB) : hbi8, PROBE_SKIP(5) ? (float*)(args.ws + WS_QZVG + 96 * MiB) : ss1, 1.0f};
        STAGGER1();
        pg8::gemm_phase<pg8::EpiResid<true, true, false, true, 2>, pg8::StaticOrder, true, true>(lds + RING_OFF, g, S, E);
    }
    SEAM(5);

    if (IN(6)) {
        pg8::Gemm g{(const bf16*)hbi8, (const bf16*)W_fgu8, T, 2 * FF, 512, 0, nullptr, 0}; pg8::StaticOrder S; S.init(T, 2 * FF, G, bid);
        RSTD_TABLE(S, ss1, true)
        pg8::EpiSwiglu<1, false, true> E{actf, FF, ss1, 22, 1.0f / (I8_SA * I8_SW), 1.0f, rsl, pml, PROBE_SKIP(6)};
        STAGGER();
        pg8::gemm_phase<pg8::EpiSwiglu<1, false, true>, pg8::StaticOrder, true, true, 2>(lds + RING_OFF, g, S, E);
    }
    SEAM(6);

    if (IN(7)) {
        pg8::Gemm g{actf, W_fd, T, 1024, FF, 0, nullptr, 0}; pg8::StaticOrder S; S.init(T, 1024, G, bid);
        pg8::EpiResid<true, true, false, true, 1> E{hb, nullptr, PROBE_SKIP(7) ? (bf16*)(args.ws + WS_KVT) : hb, PROBE_SKIP(7) ? (unsigned char*)(args.ws + WS_KVT + 32 * MiB) : hb8, PROBE_SKIP(7) ? (float*)(args.ws + WS_KVT + 48 * MiB) : ss2, 1.0f};
        STAGGER1();
        pg8::gemm_phase<pg8::EpiResid<true, true, false, true, 1>, pg8::StaticOrder, true, true>(lds + RING_OFF, g, S, E);
    }
    SEAM(7);

    if (IN(8)) {
        pg8::Gemm g{(const bf16*)hb8, (const bf16*)W_kvq8, T, NKVQ, 512, 0, nullptr, 0}; pg8::StaticOrder S; S.init(T, NKVQ, G, bid);
        RSTD_TABLE(S, ss2, true)
        pg8::EpiScale<1, false> E{kvq, NKVQ, ss2, cosT, sinT, QSCALE, PROBE_SKIP(8), 1.0f / (FP8_SA * FP8_SW1), rsl, pml};
        STAGGER();
        pg8::gemm_phase<pg8::EpiScale<1, false>, pg8::StaticOrder, MOE_ALIGN, F8_SP2, 1>(lds + RING_OFF, g, S, E);
    }
    SEAM(8);

    if (IN(9)) {
        LAS char* Kimg = (LAS char*)(lds);
        LAS char* Vimg = (LAS char*)(lds + 49152);
        const int r32 = lane & 31, hh = lane >> 5, q4 = (lane & 15) >> 2, p4 = lane & 3, blk = (lane >> 4) & 1;
        float* lse = (float*)(args.ws + WS_LSE);
        const int gper = (3072 + G - 1) / G; const int gend = (bid + 1) * gper < 3072 ? (bid + 1) * gper : 3072;
        v4u pre[6];
#define ATT_CV(w, lo, hi) do { const f32x2_t a_ = __builtin_amdgcn_cvt_pk_f32_fp8((int)(w), false), b_ = __builtin_amdgcn_cvt_pk_f32_fp8((int)(w), true); lo = cvtpk(a_[0], a_[1]); hi = cvtpk(b_[0], b_[1]); } while (0)
#define ATT_DECODE(grp_) const int task0_ = (grp_) * 8; const int br = task0_ >> 13, rem_ = task0_ & 8191, bh = rem_ >> 7, sub_ = rem_ & 127; \
        const int dil = br == 0 ? 1 : (br == 1 ? 4 : 16), nq = 128 / dil, r = sub_ / nq, qt0 = sub_ - r * nq; const int Lsub = SEQ / dil; \
        const unsigned char* kbase = kvq8 + (size_t)br * T * 1024 + ((size_t)bh * 4096 + (size_t)r * Lsub) * 64; const unsigned char* vbase = kbase + (size_t)3 * T * 1024;
#define ATT_LOAD(grp_) do { ATT_DECODE(grp_) _Pragma("unroll") for (int c = 0; c < 6; ++c) { const int idx = tid + 512 * c; const int row = (c < 3 ? idx : idx - 1536) >> 2, qc = idx & 3; \
            int lk = 32 * qt0 - 128 + row; lk = lk < 0 ? 0 : lk; pre[c] = *(const v4u*)((c < 3 ? kbase : vbase) + (size_t)lk * 64 + 16 * qc); } } while (0)
        if (bid * gper < gend) ATT_LOAD(bid * gper);
        for (int grp = bid * gper; grp < gend; ++grp) {
            __syncthreads();
#pragma unroll
            for (int c = 0; c < 6; ++c) { const int idx = tid + 512 * c; const int row = (c < 3 ? idx : idx - 1536) >> 2, qc = idx & 3;
                v4u lo, hi; ATT_CV(pre[c].x, lo.x, lo.y); ATT_CV(pre[c].y, lo.z, lo.w); ATT_CV(pre[c].z, hi.x, hi.y); ATT_CV(pre[c].w, hi.z, hi.w);
                LAS char* img = (c < 3 ? Kimg : Vimg) + row * 128;
                *(LAS v4u*)(img + (((2 * qc) ^ (row & 7)) << 4)) = lo; *(LAS v4u*)(img + (((2 * qc + 1) ^ (row & 7)) << 4)) = hi; }
            __syncthreads();
            if (grp + 1 < gend) ATT_LOAD(grp + 1);
            ATT_DECODE(grp)
            const int b = bh >> 4, h = bh & 15, qt = qt0 + wave;
            const size_t tok0 = (size_t)b * SEQ + r;
            const size_t tokq = tok0 + (size_t)dil * (32 * qt + r32);
            const unsigned char* qp = kbase + (size_t)6 * T * 1024 + (size_t)(32 * qt + r32) * 64 + 8 * hh;
            bf16x8 qf[4];
#pragma unroll
            for (int s4 = 0; s4 < 4; ++s4) { const unsigned long long q8 = *(const unsigned long long*)(qp + 16 * s4);
                const f32x2_t a0 = __builtin_amdgcn_cvt_pk_f32_fp8((int)(unsigned)q8, false), a1 = __builtin_amdgcn_cvt_pk_f32_fp8((int)(unsigned)q8, true);
                const f32x2_t a2 = __builtin_amdgcn_cvt_pk_f32_fp8((int)(unsigned)(q8 >> 32), false), a3 = __builtin_amdgcn_cvt_pk_f32_fp8((int)(unsigned)(q8 >> 32), true);
                const float qs = 1.0f / 1024.0f;
                qf[s4] = __builtin_bit_cast(bf16x8, (v4u){cvtpk(a0[0] * qs, a0[1] * qs), cvtpk(a1[0] * qs, a1[1] * qs), cvtpk(a2[0] * qs, a2[1] * qs), cvtpk(a3[0] * qs, a3[1] * qs)}); }
            f32x16 S[5];
#pragma unroll
            for (int j = 0; j < 5; ++j) {
                const int row = 32 * (wave + j) + r32; const LAS char* kr = Kimg + row * 128;
#pragma unroll
                for (int i = 0; i < 16; ++i) S[j][i] = 0.f;
#pragma unroll
                for (int s4 = 0; s4 < 4; ++s4) { const bf16x8 kf = *(const LAS bf16x8*)(kr + (((2 * s4 + hh) ^ (row & 7)) << 4)); S[j] = MFMA32(kf, qf[s4], S[j]); }
            }
#pragma unroll
            for (int i = 0; i < 16; ++i) { const int key = crow(i, hh); S[0][i] = (key >= r32) ? S[0][i] : -INFINITY; S[4][i] = (key <= r32) ? S[4][i] : -INFINITY; }
            if (qt < 4) {
#pragma unroll
                for (int j = 0; j < 4; ++j)
#pragma unroll
                    for (int i = 0; i < 16; ++i) S[j][i] = (32 * qt - 128 + 32 * j + crow(i, hh) >= 0) ? S[j][i] : -INFINITY; }
            float mx = -INFINITY;
#pragma unroll
            for (int j = 0; j < 5; ++j)
#pragma unroll
                for (int i = 0; i < 16; ++i) mx = fmaxf(mx, S[j][i]);
            mx = fmaxf(mx, __shfl_xor(mx, 32));
            float ls = 0.f;
#pragma unroll
            for (int j = 0; j < 5; ++j)
#pragma unroll
                for (int i = 0; i < 16; ++i) { const float pz = __builtin_amdgcn_exp2f(S[j][i] - mx); S[j][i] = pz; ls += pz; }
            ls += __shfl_xor(ls, 32);
            f32x16 O0, O1;
#pragma unroll
            for (int i = 0; i < 16; ++i) { O0[i] = 0.f; O1[i] = 0.f; }
#pragma unroll
            for (int j = 0; j < 5; ++j) {
#pragma unroll
                for (int s2 = 0; s2 < 2; ++s2) { const bf16x8 pb = PACK8(S[j], s2);
                    const int R = 32 * (wave + j) + 16 * s2 + 4 * hh + q4;
                    const LAS char* rb = Vimg + R * 128 + 8 * (p4 & 1); const int sw = R & 7, c0 = 2 * blk + (p4 >> 1);
                    const bf16x8 va0 = trpair(rb + ((c0 ^ sw) << 4), rb + 8 * 128 + ((c0 ^ sw) << 4)), va1 = trpair(rb + (((4 + c0) ^ sw) << 4), rb + 8 * 128 + (((4 + c0) ^ sw) << 4));
                    O0 = MFMA32(va0, pb, O0); O1 = MFMA32(va1, pb, O1); }
            }
            const float inv = 1.0f / (16.0f * ls);
            bf16* op = oa + (size_t)br * T * 1024 + tokq * 1024 + h * 64 + 4 * hh;
#pragma unroll
            for (int g = 0; g < 4; ++g) {
                *(unsigned long long*)(op + 8 * g) = (unsigned long long)cvtpk(O0[4 * g] * inv, O0[4 * g + 1] * inv) | ((unsigned long long)cvtpk(O0[4 * g + 2] * inv, O0[4 * g + 3] * inv) << 32);
                *(unsigned long long*)(op + 32 + 8 * g) = (unsigned long long)cvtpk(O1[4 * g] * inv, O1[4 * g + 1] * inv) | ((unsigned long long)cvtpk(O1[4 * g + 2] * inv, O1[4 * g + 3] * inv) << 32); }
            if (hh == 0) lse[(size_t)br * T * 16 + tokq * 16 + h] = mx + __log2f(ls);
        }
#undef ATT_DECODE
#undef ATT_LOAD
#undef ATT_CV
    }
    SEAM(9);

    if (IN(10)) {
        const float* lse = (const float*)(args.ws + WS_LSE);
        for (int t = gw; t < T; t += NGW) {
            const int head = lane >> 2;
            const float l0 = lse[(size_t)t * 16 + head], l1 = lse[(size_t)T * 16 + (size_t)t * 16 + head], l2 = lse[(size_t)2 * T * 16 + (size_t)t * 16 + head];
            const float mm = fmaxf(l0, fmaxf(l1, l2));
            float w0 = __builtin_amdgcn_exp2f(l0 - mm), w1 = __builtin_amdgcn_exp2f(l1 - mm), w2 = __builtin_amdgcn_exp2f(l2 - mm);
            const float inv = 1.0f / (w0 + w1 + w2); w0 *= inv; w1 *= inv; w2 *= inv;
            bf16* p0 = oa + (size_t)t * 1024 + 16 * lane;
#pragma unroll
            for (int hf2 = 0; hf2 < 2; ++hf2) {
                const v4u a = *(const v4u*)(p0 + 8 * hf2), bq = *(const v4u*)(p0 + (size_t)T * 1024 + 8 * hf2), cq = *(const v4u*)(p0 + (size_t)2 * T * 1024 + 8 * hf2);
                const float s64 = 64.0f;
                const unsigned lo = pg8::pk4_fp8((w0 * bflo(a.x) + w1 * bflo(bq.x) + w2 * bflo(cq.x)) * s64, (w0 * bfhi(a.x) + w1 * bfhi(bq.x) + w2 * bfhi(cq.x)) * s64,
                                                 (w0 * bflo(a.y) + w1 * bflo(bq.y) + w2 * bflo(cq.y)) * s64, (w0 * bfhi(a.y) + w1 * bfhi(bq.y) + w2 * bfhi(cq.y)) * s64);
                const unsigned hi = pg8::pk4_fp8((w0 * bflo(a.z) + w1 * bflo(bq.z) + w2 * bflo(cq.z)) * s64, (w0 * bfhi(a.z) + w1 * bfhi(bq.z) + w2 * bfhi(cq.z)) * s64,
                                                 (w0 * bflo(a.w) + w1 * bflo(bq.w) + w2 * bflo(cq.w)) * s64, (w0 * bfhi(a.w) + w1 * bfhi(bq.w) + w2 * bfhi(cq.w)) * s64);
                *(unsigned long long*)(oa8 + (size_t)t * 1024 + 16 * lane + 8 * hf2) = (unsigned long long)lo | ((unsigned long long)hi << 32); }
        }
    }
    SEAM(10);

    if (IN(11)) {
        pg8::Gemm g{(const bf16*)oa8, (const bf16*)W_od8, T, 1024, 512, 0, nullptr, 0}; pg8::StaticOrder S; S.init(T, 1024, G, bid);
        pg8::EpiResid<false, true, false, true, 0> E{hb, nullptr, PROBE_SKIP(11) ? (bf16*)(args.ws + WS_KVQ) : hb, nullptr, nullptr, 1.0f / (64.0f * FP8_SW1)};
        STAGGER1();
        pg8::gemm_phase<pg8::EpiResid<false, true, false, true, 0>, pg8::StaticOrder, true, true, 1>(lds + RING_OFF, g, S, E);
    }
    SEAM(11);

    if (IN(12)) {
        const float* gain = ffn_norm + 1024;
#if defined(PROBE_K)
        if (!(args.li == 1 && lo == 12))
#endif
        for (int t = gw; t < T; t += NGW) {
            const v4u ha = *((const v4u*)(hb + (size_t)t * D) + 2 * lane), hc = *((const v4u*)(hb + (size_t)t * D) + 2 * lane + 1);
            float hv[16];
            hv[0] = bflo(ha.x); hv[1] = bfhi(ha.x); hv[2] = bflo(ha.y); hv[3] = bfhi(ha.y); hv[4] = bflo(ha.z); hv[5] = bfhi(ha.z); hv[6] = bflo(ha.w); hv[7] = bfhi(ha.w);
            hv[8] = bflo(hc.x); hv[9] = bfhi(hc.x); hv[10] = bflo(hc.y); hv[11] = bfhi(hc.y); hv[12] = bflo(hc.z); hv[13] = bfhi(hc.z); hv[14] = bflo(hc.w); hv[15] = bfhi(hc.w);
            float s = 0.f;
#pragma unroll
            for (int i = 0; i < 16; ++i) s += hv[i] * hv[i];
            s = wave_sum(s);
            const float rstd = __builtin_amdgcn_rsqf(s * (1.f / 1024.f) + EPS);
            float lg[8];
#pragma unroll
            for (int e = 0; e < 8; ++e) lg[e] = 0.f;
#pragma unroll
            for (int i = 0; i < 16; ++i) { const int k = 16 * lane + i; const float xv = hv[i] * gain[k];
                const f32x4 w0 = *(const f32x4*)(moe_wr + k * 8), w1 = *(const f32x4*)(moe_wr + k * 8 + 4);
                lg[0] += xv * w0[0]; lg[1] += xv * w0[1]; lg[2] += xv * w0[2]; lg[3] += xv * w0[3]; lg[4] += xv * w1[0]; lg[5] += xv * w1[1]; lg[6] += xv * w1[2]; lg[7] += xv * w1[3]; }
#pragma unroll
            for (int e = 0; e < 8; ++e) lg[e] = wave_sum(lg[e]) * rstd;
            int e1 = 0; float m1 = lg[0];
#pragma unroll
            for (int e = 1; e < 8; ++e) if (lg[e] > m1) { m1 = lg[e]; e1 = e; }
            int e2 = -1; float m2 = -INFINITY;
#pragma unroll
            for (int e = 0; e < 8; ++e) if (e != e1 && lg[e] > m2) { m2 = lg[e]; e2 = e; }
            const float p2 = __expf(m2 - m1); const float w1v = 1.f / (1.f + p2), w2v = p2 / (1.f + p2);
            if (lane == 0) { const unsigned pa = atomicAdd((unsigned*)(ctl + CW_CNT + 64 * e1), 1u), pb = atomicAdd((unsigned*)(ctl + CW_CNT + 64 * e2), 1u);
                tok_e[2 * t] = e1; tok_e[2 * t + 1] = e2; tok_p[2 * t] = (int)pa; tok_p[2 * t + 1] = (int)pb; tok_w[2 * t] = w1v; tok_w[2 * t + 1] = w2v; ss3[t] = s;
                rowtok[e1 * 16384 + (int)pa] = t; rowtok[e2 * 16384 + (int)pb] = t; }
            {
                const float rs = rstd * FP8_SA; v4u o;
                o.x = pg8::pk4_fp8(hv[0] * rs, hv[1] * rs, hv[2] * rs, hv[3] * rs); o.y = pg8::pk4_fp8(hv[4] * rs, hv[5] * rs, hv[6] * rs, hv[7] * rs);
                o.z = pg8::pk4_fp8(hv[8] * rs, hv[9] * rs, hv[10] * rs, hv[11] * rs); o.w = pg8::pk4_fp8(hv[12] * rs, hv[13] * rs, hv[14] * rs, hv[15] * rs);
                *((v4u*)(a8tok + (size_t)t * D) + lane) = o; }
        }
        LAS float* scr = (LAS float*)(lds + RING_OFF + wave * 16384);
        constexpr int I_G = 16 * 112, I_D = 56 * 32, I_E = 2 * I_G + I_D;
        for (int it = gw; it < NE * I_E; it += NGW) {
            const int e = it / I_E; int r = it - e * I_E;
            if (r < I_G) { transpose_item8(moe_wg + (size_t)e * 1024 * FFE, FFE, 1024, gain, FP8_SW1, W_gu + (size_t)e * 7168 * 1024, 1, 0, scr, r / 112, r % 112, lane); continue; } r -= I_G;
            if (r < I_G) { transpose_item8(moe_wu + (size_t)e * 1024 * FFE, FFE, 1024, gain, FP8_SW1, W_gu + (size_t)e * 7168 * 1024, 1, 128, scr, r / 112, r % 112, lane); continue; } r -= I_G;
            transpose_item8(moe_wd + (size_t)e * FFE * 1024, 1024, FFE, nullptr, FP8_SW2, W_d + (size_t)e * 1024 * FFE, 0, 0, scr, r / 32, r % 32, lane);
        }
    }
    SEAM(12);

    int tp1 = 0, tp2 = 0, tp3 = 0, tp4 = 0, tp5 = 0, tp6 = 0, tp7 = 0, tp8 = 0;
    if (hi > 13 && lo <= 15) {
        int c[8];
#pragma unroll
        for (int e = 0; e < 8; ++e) c[e] = (int)((__hip_atomic_load(ctl + CW_CNT + 64 * e, RLX_AGENT) + 255u) >> 8);
        tp1 = c[0]; tp2 = tp1 + c[1]; tp3 = tp2 + c[2]; tp4 = tp3 + c[3]; tp5 = tp4 + c[4]; tp6 = tp5 + c[5]; tp7 = tp6 + c[6]; tp8 = tp7 + c[7];
    }


    if (IN(14)) {
        for (int t = bid * NTHR + tid; t < 2 * T; t += G * NTHR) { const int e = tok_e[t];
            const int tb = e == 0 ? 0 : e == 1 ? tp1 : e == 2 ? tp2 : e == 3 ? tp3 : e == 4 ? tp4 : e == 5 ? tp5 : e == 6 ? tp6 : tp7;
            const int dst = tb * 256 + tok_p[t]; w_sorted[dst] = tok_w[t]; tok_d[t] = dst; }
        pg8::Gemm g{(const bf16*)a8tok, (const bf16*)W_gu, tp8 * 256, 7168, 512, 0, rowtok, T - 1};
        pg8::MoeOrder S{tp8, 28, tp8 * 28, G, bid, tp1, tp2, tp3, tp4, tp5, tp6, tp7};
        pg8::EpiSwiglu<2, true, false> E{actm, FFE, nullptr, 28, 1.0f / (FP8_SA * FP8_SW1), FP8_SACT, 0u, 0, PROBE_SKIP(14)};
        STAGGER();
        pg8::gemm_phase<pg8::EpiSwiglu<2, true, false>, pg8::MoeOrder, MOE_ALIGN, F8_SP2, 1, true>(lds + RING_OFF, g, S, E);
    }
    SEAM(14);

    if (IN(15)) {
        const int nmain = tp8 < 128 ? tp8 : 128;
        { pg8::Gemm g{(const bf16*)actm, (const bf16*)W_d, nmain * 256, 1024, FFE / 2, 0, nullptr, 0};
          pg8::MoeOrder S{nmain, 4, nmain * 4, G, bid, tp1, tp2, tp3, tp4, tp5, tp6, tp7};
          pg8::EpiDownMoe E{ymoe, w_sorted, 1.0f / (FP8_SACT * FP8_SW2)};
          pg8::gemm_phase<pg8::EpiDownMoe, pg8::MoeOrder, true, F8_SP2, 1>(lds + RING_OFF, g, S, E); }
        if (tp8 > 128) {
            __syncthreads();
            pg8::Gemm g{(const bf16*)actm, (const bf16*)W_d, tp8 * 256, 1024, FFE / 2, 4, nullptr, 0};
            pg8::LeftOrder S{128, (tp8 - 128) * 4 * 7, G, bid, 7, tp1, tp2, tp3, tp4, tp5, tp6, tp7};
            pg8::EpiDownPart E{ypart, w_sorted, 1.0f / (FP8_SACT * FP8_SW2), 32768, PART_ROWS};
            pg8::gemm_phase<pg8::EpiDownPart, pg8::LeftOrder, true, true, 1>(lds + RING_OFF, g, S, E);
        }
    }
    SEAM(15);

    if (IN(16)) {
        for (int t = gw; t < T; t += NGW) {
            const int d0 = tok_d[2 * t], d1 = tok_d[2 * t + 1];
            GAS f32x4* hr = (GAS f32x4*)(hf + (size_t)t * D) + lane;
            const GAS unsigned long long* h8p = (const GAS unsigned long long*)(hb + (size_t)t * D) + lane;
            f32x4 v[4]; float s = 0.f;
#pragma unroll
            for (int j = 0; j < 4; ++j) { const unsigned long long hq = h8p[64 * j];
                v[j] = (f32x4){bflo((unsigned)hq), bfhi((unsigned)hq), bflo((unsigned)(hq >> 32)), bfhi((unsigned)(hq >> 32))}; }
#pragma unroll
            for (int k2 = 0; k2 < 2; ++k2) { const int dd = k2 ? d1 : d0;
                if (dd < 32768) { const GAS unsigned long long* yp = (const GAS unsigned long long*)(ymoe + (size_t)dd * D) + lane;
#pragma unroll
                    for (int j = 0; j < 4; ++j) { const unsigned long long a = yp[64 * j]; v[j].x += bflo((unsigned)a); v[j].y += bfhi((unsigned)a); v[j].z += bflo((unsigned)(a >> 32)); v[j].w += bfhi((unsigned)(a >> 32)); } }
                else {
                    f32x4 ys[4];
#pragma unroll
                    for (int j = 0; j < 4; ++j) ys[j] = (f32x4){0.f, 0.f, 0.f, 0.f};
                    for (int ks = 0; ks < 7; ++ks) { const GAS unsigned long long* yp = (const GAS unsigned long long*)(ypart + ((size_t)ks * PART_ROWS + (dd - 32768)) * D) + lane;
#pragma unroll
                        for (int j = 0; j < 4; ++j) { const unsigned long long a = yp[64 * j]; ys[j].x += bflo((unsigned)a); ys[j].y += bfhi((unsigned)a); ys[j].z += bflo((unsigned)(a >> 32)); ys[j].w += bfhi((unsigned)(a >> 32)); } }
#pragma unroll
                    for (int j = 0; j < 4; ++j) v[j] = v[j] + ys[j]; } }
#pragma unroll
            for (int j = 0; j < 4; ++j) s += (v[j].x * v[j].x + v[j].y * v[j].y) + (v[j].z * v[j].z + v[j].w * v[j].w);
            s = wave_sum(s);
            const float rstd = __builtin_amdgcn_rsqf(s * (1.f / 1024.f) + EPS);
#pragma unroll
            for (int j = 0; j < 4; ++j) { const f32x4 gn = *((const GAS f32x4*)final_norm + lane + 64 * j); hr[64 * j] = v[j] * rstd * gn; }
        }
    }
#undef IN
#undef SEAM
#undef xin
#undef attn_norm
#undef ffn_norm
#undef hgrn_w_in
#undef hgrn_lb
#undef hgrn_onorm
#undef hgrn_w_out
#undef kv_norm
#undef w_kv
#undef dil_w_q
#undef dil_w_out
#undef ffn_wg
#undef ffn_wu
#undef ffn_wd
#undef moe_wr
#undef moe_wg
#undef moe_wu
#undef moe_wd
#undef final_norm
#undef hf
#undef hb
#undef hb8
#undef a8tok
#undef rowtok
#undef ypart
#undef W_od8
#undef oa8
#undef W_in8
#undef xq8
#undef hbi8
#undef W_kvq8
#undef W_fgu8
#undef W_fd8
#undef actf8
#undef cosT
#undef sinT
#undef lbv
#undef ss0
#undef ss1
#undef ss2
#undef ss3
#undef W_in
#undef W_oh
#undef W_fgu
#undef W_fd
#undef W_kvq
#undef W_od
#undef W_gu
#undef W_d
#undef qzvg
#undef kvT
#undef stT
#undef oh
#undef actf
#undef kvq
#undef kvq8
#undef oa
#undef asort
#undef actm
#undef ymoe
#undef decay
#undef tok_e
#undef tok_p
#undef tok_w
#undef tok_d
#undef ss_sorted
#undef w_sorted
#undef ctl
}

#ifndef MK_N_LAUNCHES
#define MK_N_LAUNCHES 1
#endif
extern "C" void kernel_launch(void* const* d_in, const int* in_sizes, int n_in, void* d_out, int out_size, void* d_ws, size_t ws_size, hipStream_t stream) {
    static int grid = 0;
    if (grid == 0) {
        if (n_in != 19 || in_sizes[0] != T * D || out_size != T * D || ws_size < WS_END) { fprintf(stderr, "kernel_launch: unexpected shapes / workspace (n_in %d, ws %zu); nothing launched\n", n_in, ws_size); grid = -1; return; }
        int dev = 0, cus = 0, per_cu = 0;
        if (hipGetDevice(&dev) != hipSuccess || hipDeviceGetAttribute(&cus, hipDeviceAttributeMultiprocessorCount, dev) != hipSuccess) { grid = -1; return; }
        if (hipFuncSetAttribute((const void*)fwd_kernel, hipFuncAttributeMaxDynamicSharedMemorySize, LDS_BYTES) != hipSuccess) { fprintf(stderr, "kernel_launch: hipFuncSetAttribute failed\n"); grid = -1; return; }
        if (hipOccupancyMaxActiveBlocksPerMultiprocessor(&per_cu, (const void*)fwd_kernel, NTHR, LDS_BYTES) != hipSuccess || per_cu < 1) { fprintf(stderr, "kernel_launch: occupancy query reports %d\n", per_cu); }
        (void)hipGetLastError();
        grid = cus;
        if (grid != 256) { fprintf(stderr, "kernel_launch: built for a 256-CU device (got %d CUs); nothing launched\n", grid); grid = -1; return; }
    }
    if (grid < 0) return;
    if (hipMemsetAsync((char*)d_ws + WS_CTL, 0, CTL_ZERO_BYTES, stream) != hipSuccess) return;
    Args a{};
    for (int i = 0; i < 19; ++i) a.in[i] = (const float*)d_in[i];
    a.out = (float*)d_out; a.ws = (unsigned char*)d_ws;
#if defined(PROBE_K)
    a.ph_lo = 0; a.ph_hi = PROBE_K + 1; a.li = 0; hipLaunchKernelGGL(fwd_kernel, dim3(grid), dim3(NTHR), LDS_BYTES, stream, a);
    a.ph_lo = PROBE_K; a.ph_hi = NPHASE; a.li = 1; hipLaunchKernelGGL(fwd_kernel, dim3(grid), dim3(NTHR), LDS_BYTES, stream, a);
    return;
#endif
    if (MK_N_LAUNCHES == 1) { a.ph_lo = 0; a.ph_hi = NPHASE; hipLaunchKernelGGL(fwd_kernel, dim3(grid), dim3(NTHR), LDS_BYTES, stream, a); }
    else for (int p = 0; p < NPHASE; ++p) { a.ph_lo = p; a.ph_hi = p + 1; hipLaunchKernelGGL(fwd_kernel, dim3(grid), dim3(NTHR), LDS_BYTES, stream, a); }
}
```
